# Optimizing an MI355X kernel written in HIP

```python
import math
import jax, jax.numpy as jnp
from jax import lax
import numpy as np

D_MODEL = 1024
BATCH = 2
SEQ = 16384
DEPTH = 1

N_MEM = 256
D_FF = 2816
D_CONV = D_MODEL
CONV_WIDTH = 31
D_SGU = D_MODEL
SGU_GROUPS = 4
CHUNK = 128
X_HEADS = 4
X_HEAD_DIM = D_MODEL // X_HEADS
D_IN = 2 * D_CONV + 2 * D_SGU + 2 * D_MODEL
EPS_RMS = 1e-6
EPS_LN = 1e-5

kernel_name = "hybrid_conformer_gmlp_memxattn_block"


def rms_norm(x, g):
    xf = x.astype(jnp.float32)
    y = xf * lax.rsqrt(jnp.mean(xf * xf, axis=-1, keepdims=True) + EPS_RMS)
    return (y * g.astype(jnp.float32)).astype(x.dtype)


def layer_norm(x, g, b):
    xf = x.astype(jnp.float32)
    mu = jnp.mean(xf, axis=-1, keepdims=True)
    xc = xf - mu
    var = jnp.mean(xc * xc, axis=-1, keepdims=True)
    y = xc * lax.rsqrt(var + EPS_LN)
    return (y * g.astype(jnp.float32) + b.astype(jnp.float32)).astype(x.dtype)


def swiglu(x, w_gu, w_down):
    gu = x @ w_gu
    g, u = jnp.split(gu, 2, axis=-1)
    return (jax.nn.silu(g) * u) @ w_down


def causal_depthwise_conv(a, w, b):
    c = a.shape[-1]
    y = lax.conv_general_dilated(
        a, w.astype(a.dtype)[:, None, :],
        window_strides=(1,), padding=[(CONV_WIDTH - 1, 0)],
        dimension_numbers=("NWC", "WIO", "NWC"),
        feature_group_count=c)
    return y + b.astype(a.dtype)


def conformer_conv_branch(a_val, a_gate, conv_w, conv_b, ln_g, ln_b, w_a_out):
    a = a_val * jax.nn.sigmoid(a_gate)
    a = causal_depthwise_conv(a, conv_w, conv_b)
    a = jax.nn.silu(layer_norm(a, ln_g, ln_b))
    return a @ w_a_out


def spatial_gating_branch(u, v, ln_g, ln_b, sgu_w, sgu_b, w_b_out):
    bsz, s, _ = u.shape
    u = jax.nn.gelu(u)
    v = layer_norm(jax.nn.gelu(v), ln_g, ln_b)
    n_chunks = s // CHUNK
    gd = D_SGU // SGU_GROUPS
    vc = v.reshape(bsz, n_chunks, CHUNK, SGU_GROUPS, gd)
    mask = jnp.tril(jnp.ones((CHUNK, CHUNK), dtype=bool))
    w_s = jnp.where(mask[None], sgu_w, 0.0).astype(v.dtype)
    mixed = jnp.einsum("gts,bcsgd->bctgd", w_s, vc)
    mixed = mixed + jnp.transpose(sgu_b)[None, None, :, :, None].astype(v.dtype)
    out = u * mixed.reshape(bsz, s, D_SGU)
    return out @ w_b_out


def memory_cross_attention(xn, memn, w_q, w_kv, w_o):
    bsz, s, _ = xn.shape
    q = (xn @ w_q).reshape(bsz, s, X_HEADS, X_HEAD_DIM)
    kv = memn @ w_kv
    k, v = jnp.split(kv, 2, axis=-1)
    k = k.reshape(bsz, N_MEM, X_HEADS, X_HEAD_DIM)
    v = v.reshape(bsz, N_MEM, X_HEADS, X_HEAD_DIM)
    scores = jnp.einsum("bshd,bmhd->bhsm", q.astype(jnp.float32), k.astype(jnp.float32))
    p = jax.nn.softmax(scores * (1.0 / math.sqrt(X_HEAD_DIM)), axis=-1).astype(v.dtype)
    o = jnp.einsum("bhsm,bmhd->bshd", p, v).reshape(bsz, s, D_MODEL)
    return o @ w_o


def setup_inputs(seed: int = 0) -> dict:
    key = jax.random.key(seed)
    ks = jax.random.split(key, 32)

    def dense(k, shape, fan_in):
        return jax.random.normal(k, shape, jnp.float32) * (fan_in ** -0.5)

    def gain(k, shape):
        return 1.0 + 0.02 * jax.random.normal(k, shape, jnp.float32)

    def small(k, shape):
        return 0.02 * jax.random.normal(k, shape, jnp.float32)

    L = DEPTH
    return {
        "x": jax.random.normal(ks[0], (BATCH, SEQ, D_MODEL), jnp.float32),
        "mem": jax.random.normal(ks[1], (BATCH, N_MEM, D_MODEL), jnp.float32),
        "ffn1_norm": gain(ks[2], (L, D_MODEL)),
        "ffn1_w_gu": dense(ks[3], (L, D_MODEL, 2 * D_FF), D_MODEL),
        "ffn1_w_down": dense(ks[4], (L, D_FF, D_MODEL), D_FF),
        "mix_norm": gain(ks[5], (L, D_MODEL)),
        "w_in": dense(ks[6], (L, D_MODEL, D_IN), D_MODEL),
        "b_in": small(ks[7], (L, D_IN)),
        "conv_w": dense(ks[8], (L, CONV_WIDTH, D_CONV), CONV_WIDTH),
        "conv_b": small(ks[9], (L, D_CONV)),
        "conv_ln_g": gain(ks[10], (L, D_CONV)),
        "conv_ln_b": small(ks[11], (L, D_CONV)),
        "w_a_out": dense(ks[12], (L, D_CONV, D_MODEL), D_CONV),
        "sgu_ln_g": gain(ks[13], (L, D_SGU)),
        "sgu_ln_b": small(ks[14], (L, D_SGU)),
        "sgu_w": dense(ks[15], (L, SGU_GROUPS, CHUNK, CHUNK), CHUNK),
        "sgu_b": gain(ks[16], (L, SGU_GROUPS, CHUNK)),
        "w_b_out": dense(ks[17], (L, D_SGU, D_MODEL), D_SGU),
        "w_out": dense(ks[18], (L, D_MODEL, D_MODEL), D_MODEL),
        "xattn_norm": gain(ks[19], (L, D_MODEL)),
        "mem_norm": gain(ks[20], (L, D_MODEL)),
        "w_q": dense(ks[21], (L, D_MODEL, D_MODEL), D_MODEL),
        "w_kv": dense(ks[22], (L, D_MODEL, 2 * D_MODEL), D_MODEL),
        "w_o": dense(ks[23], (L, D_MODEL, D_MODEL), D_MODEL),
        "ffn2_norm": gain(ks[24], (L, D_MODEL)),
        "ffn2_w_gu": dense(ks[25], (L, D_MODEL, 2 * D_FF), D_MODEL),
        "ffn2_w_down": dense(ks[26], (L, D_FF, D_MODEL), D_FF),
        "final_norm": gain(ks[27], (D_MODEL,)),
    }


def reference(x, mem, ffn1_norm, ffn1_w_gu, ffn1_w_down, mix_norm, w_in, b_in,
              conv_w, conv_b, conv_ln_g, conv_ln_b, w_a_out,
              sgu_ln_g, sgu_ln_b, sgu_w, sgu_b, w_b_out, w_out,
              xattn_norm, mem_norm, w_q, w_kv, w_o,
              ffn2_norm, ffn2_w_gu, ffn2_w_down, final_norm):
    split_at = [D_CONV, 2 * D_CONV, 2 * D_CONV + D_SGU, 2 * D_CONV + 2 * D_SGU,
                2 * D_CONV + 2 * D_SGU + D_MODEL]
    h = x
    for l in range(DEPTH):
        h = h + 0.5 * swiglu(rms_norm(h, ffn1_norm[l]), ffn1_w_gu[l], ffn1_w_down[l])

        n = rms_norm(h, mix_norm[l])
        p = n @ w_in[l] + b_in[l]
        a_val, a_gate, b_u, b_v, g_a, g_b = jnp.split(p, split_at, axis=-1)
        y_a = conformer_conv_branch(a_val, a_gate, conv_w[l], conv_b[l],
                                    conv_ln_g[l], conv_ln_b[l], w_a_out[l])
        y_b = spatial_gating_branch(b_u, b_v, sgu_ln_g[l], sgu_ln_b[l],
                                    sgu_w[l], sgu_b[l], w_b_out[l])
        merged = jax.nn.sigmoid(g_a) * y_a + jax.nn.sigmoid(g_b) * y_b
        h = h + merged @ w_out[l]

        h = h + memory_cross_attention(rms_norm(h, xattn_norm[l]), rms_norm(mem, mem_norm[l]),
                                       w_q[l], w_kv[l], w_o[l])

        h = h + 0.5 * swiglu(rms_norm(h, ffn2_norm[l]), ffn2_w_gu[l], ffn2_w_down[l])
    return rms_norm(h, final_norm)
```

```cpp
#include <hip/hip_runtime.h>
#include <hip/hip_cooperative_groups.h>
#include <cstdio>
namespace cg = cooperative_groups;

#include <cstring>
#include <utility>
namespace pg8 {
#define PG8_LAS __attribute__((address_space(3)))
typedef unsigned short bf16_t;
typedef short bf16x8 __attribute__((ext_vector_type(8)));
typedef float f32x4 __attribute__((ext_vector_type(4)));
typedef unsigned u32x4 __attribute__((ext_vector_type(4)));
constexpr int BM = 256, BK = 64, HALF = 128, HTB = HALF * BK * 2  , STAGE_BYTES = 8 * HTB, NXCD = 8, WGM = 8;

__host__ __device__ __forceinline__ int lds_byte(int r, int c) { const int st = (r >> 4) * 2 + (c >> 5), rr = r & 15, cc = c & 31, ob = rr * 64 + cc * 2; return st * 1024 + (ob ^ (((ob >> 9) & 1) << 5)); }
__host__ __device__ __forceinline__ void stage_rc(int b, int& R, int& C) { const int st = b / 1024, sb = b % 1024, swz = sb ^ (((sb >> 9) & 1) << 5); R = (st >> 1) * 16 + swz / 64; C = (st & 1) * 32 + (swz % 64) / 2; }
__host__ __device__ __forceinline__ int perm32(int rho) { const int n = rho >> 4, i = rho & 15; return 8 * (i >> 2) + 4 * n + (i & 3); }

struct Unit { int pm, pn; };
struct Gemm { const bf16_t* A; const bf16_t* Bt; int M, N, K; };

struct StaticOrder {
    int nM, nN, nwg, G, c;
    __host__ __device__ void init(int M, int N, int G_, int c_) { nM = M / BM; nN = N / BM; nwg = nM * nN; G = G_; c = c_; }
    __host__ __device__ bool next(int i, Unit& u) const {
        const long L = (long)i * G + c; if (L >= nwg) return false;
        int wgid = (int)L; { const int q = nwg / NXCD, r = nwg % NXCD, xcd = wgid % NXCD, off = wgid / NXCD; wgid = (xcd < r ? xcd * (q + 1) : r * (q + 1) + (xcd - r) * q) + off; }
        const int nig = WGM * nN, gid = wgid / nig, fm = gid * WGM, gsz = (nM - fm) < WGM ? (nM - fm) : WGM;
        u.pm = fm + ((wgid % nig) % gsz); u.pn = (wgid % nig) / gsz; return true;
    }
    __device__ __forceinline__ void a_ready(const Unit&) const {}
    __device__ __forceinline__ void done(const Unit&) const {}
};

template <class Epi, class Sched, bool ALIGN_EPI = false, bool SP2 = false>
__device__ __forceinline__ void gemm_phase(PG8_LAS unsigned char* lds, const Gemm g, const Sched& S, const Epi& E) {
    const int tid = threadIdx.x, wid = __builtin_amdgcn_readfirstlane(tid >> 6), lane = tid & 63, wr = wid >> 2, wc = wid & 3, fr = lane & 15, fq = lane >> 4;
    const int K = g.K, nt = K / BK;
    unsigned voffA[2], voffB[2];
#pragma unroll
    for (int i = 0; i < 2; ++i) { int R, C; stage_rc(tid * 16 + i * 8192, R, C); const int Rb = Epi::PERM ? ((R & ~31) + perm32(R & 31)) : R;
        voffA[i] = (unsigned)(R * K + C) * 2u; voffB[i] = (unsigned)(Rb * K + C) * 2u; }
    const size_t kstep = (size_t)(BK * 2);
    const size_t hstep = (size_t)HALF * K * 2;
    const size_t tstep = 2 * hstep;
    const unsigned ldsw = (unsigned)wid * 1024u;
    const int aoff = lds_byte(wr * 64 + fr, fq * 8), boff = lds_byte(wc * 32 + fr, fq * 8);
#define PG8_SA(b, h) (((b) * 2 + (h)) * HTB)
#define PG8_SB(b, h) ((4 + (b) * 2 + (h)) * HTB)
#define PG8_STAGE(bufoff, gbase, voff) do { _Pragma("unroll") for (int _i = 0; _i < 2; ++_i) \
        __builtin_amdgcn_global_load_lds((const unsigned*)((const char*)(gbase) + (voff)[_i]), (PG8_LAS unsigned*)(lds + (bufoff) + ldsw + _i * 8192), 16, 0, 0); } while (0)
#define PG8_LDA(dst, b, h) do { _Pragma("unroll") for (int m = 0; m < 4; ++m) _Pragma("unroll") for (int k = 0; k < 2; ++k) dst[m][k] = *(const PG8_LAS bf16x8*)(lds + PG8_SA(b, h) + aoff + m * 2048 + k * 1024); } while (0)
#define PG8_LDB(dst, b, h) do { _Pragma("unroll") for (int n = 0; n < 2; ++n) _Pragma("unroll") for (int k = 0; k < 2; ++k) dst[n][k] = *(const PG8_LAS bf16x8*)(lds + PG8_SB(b, h) + boff + n * 2048 + k * 1024); } while (0)
#define PG8_MMA(ai, bj, At, Bt) do { __builtin_amdgcn_s_setprio(1); _Pragma("unroll") for (int m = 0; m < 4; ++m) _Pragma("unroll") for (int n = 0; n < 2; ++n) _Pragma("unroll") for (int k = 0; k < 2; ++k) \
        acc[ai][bj][m][n] = __builtin_amdgcn_mfma_f32_16x16x32_bf16(Bt[n][k], At[m][k], acc[ai][bj][m][n], 0, 0, 0); __builtin_amdgcn_s_setprio(0); } while (0)
#define PG8_WAIT_V(n) asm volatile("s_waitcnt vmcnt(" #n ")" ::: "memory")
#define PG8_WAIT_L(n) asm volatile("s_waitcnt lgkmcnt(" #n ")" ::: "memory")
#define PG8_BAR __builtin_amdgcn_s_barrier()
#define PG8_SCHED __builtin_amdgcn_sched_barrier(0)
    Unit cur, nxt; int ui = 0;
    if (!S.next(0, cur)) return;
    f32x4 acc[2][2][4][2];
#pragma unroll
    for (int a = 0; a < 2; ++a)
#pragma unroll
        for (int b = 0; b < 2; ++b)
#pragma unroll
            for (int m = 0; m < 4; ++m)
#pragma unroll
                for (int n = 0; n < 2; ++n) acc[a][b][m][n] = (f32x4){0.f, 0.f, 0.f, 0.f};
    bf16x8 At[4][2], B0[2][2], B1[2][2];
    const char* cA = (const char*)g.A + (size_t)cur.pm * tstep; const char* cB = (const char*)g.Bt + (size_t)cur.pn * tstep;
    S.a_ready(cur);
    if constexpr (SP2) {
        PG8_STAGE(PG8_SB(0, 0), cB, voffB); PG8_STAGE(PG8_SB(0, 1), cB + hstep, voffB); PG8_STAGE(PG8_SA(0, 0), cA, voffA); PG8_STAGE(PG8_SA(0, 1), cA + hstep, voffA);
        if (wr == 1) PG8_BAR;
        PG8_WAIT_V(2); PG8_BAR;
        PG8_STAGE(PG8_SB(1, 0), cB + kstep, voffB); PG8_STAGE(PG8_SA(1, 0), cA + kstep, voffA); PG8_STAGE(PG8_SB(1, 1), cB + hstep + kstep, voffB);
        PG8_WAIT_V(6); PG8_BAR;
    } else {
        PG8_STAGE(PG8_SB(0, 0), cB, voffB); PG8_STAGE(PG8_SA(0, 0), cA, voffA); PG8_STAGE(PG8_SB(0, 1), cB + hstep, voffB); PG8_STAGE(PG8_SA(0, 1), cA + hstep, voffA);
        if (wr == 1) PG8_BAR;
        PG8_WAIT_V(4); PG8_BAR;
        PG8_STAGE(PG8_SB(1, 0), cB + kstep, voffB); PG8_STAGE(PG8_SA(1, 0), cA + kstep, voffA); PG8_STAGE(PG8_SB(1, 1), cB + hstep + kstep, voffB);
        PG8_WAIT_V(6); PG8_BAR;
    }
    for (;;) {
        const bool has_next = S.next(ui + 1, nxt);
        const char* nA = has_next ? (const char*)g.A + (size_t)nxt.pm * tstep : cA; const char* nB = has_next ? (const char*)g.Bt + (size_t)nxt.pn * tstep : cB;
        for (int t = 0; t < nt; t += 2) {
            const bool last = (t == nt - 2);
            const char* a1 = cA + (size_t)(t + 1) * kstep;
            const char* a2 = last ? nA : cA + (size_t)(t + 2) * kstep; const char* b2 = last ? nB : cB + (size_t)(t + 2) * kstep;
            const char* a3 = a2 + kstep; const char* b3 = b2 + kstep;
            if (last && has_next) S.a_ready(nxt);
            if constexpr (SP2) {
            PG8_LDB(B0, 0, 0); PG8_LDB(B1, 0, 1); PG8_SCHED; PG8_LDA(At, 0, 0); PG8_STAGE(PG8_SA(1, 1), a1 + hstep, voffA);
            PG8_WAIT_V(8); PG8_WAIT_L(0); PG8_BAR; PG8_MMA(0, 0, At, B0); PG8_MMA(0, 1, At, B1); PG8_BAR; PG8_SCHED;
            PG8_LDA(At, 0, 1); PG8_STAGE(PG8_SB(0, 0), b2, voffB); PG8_STAGE(PG8_SB(0, 1), b2 + hstep, voffB); PG8_STAGE(PG8_SA(0, 0), a2, voffA);
            PG8_WAIT_V(8); PG8_WAIT_L(0); PG8_BAR; PG8_MMA(1, 0, At, B0); PG8_MMA(1, 1, At, B1); PG8_BAR; PG8_SCHED;
            PG8_LDB(B0, 1, 0); PG8_LDB(B1, 1, 1); PG8_SCHED; PG8_LDA(At, 1, 0); PG8_STAGE(PG8_SA(0, 1), a2 + hstep, voffA);
            PG8_WAIT_V(8); PG8_WAIT_L(0); PG8_BAR; PG8_MMA(0, 0, At, B0); PG8_MMA(0, 1, At, B1); PG8_BAR; PG8_SCHED;
            PG8_LDA(At, 1, 1); PG8_STAGE(PG8_SB(1, 0), b3, voffB); PG8_STAGE(PG8_SB(1, 1), b3 + hstep, voffB); PG8_STAGE(PG8_SA(1, 0), a3, voffA);
            PG8_WAIT_V(8); PG8_WAIT_L(0); PG8_BAR; PG8_MMA(1, 0, At, B0); PG8_MMA(1, 1, At, B1); PG8_BAR; PG8_SCHED;
            } else {
            PG8_LDB(B0, 0, 0); PG8_SCHED; PG8_LDA(At, 0, 0); PG8_STAGE(PG8_SA(1, 1), a1 + hstep, voffA);
            PG8_WAIT_L(8); PG8_BAR; PG8_WAIT_L(0); PG8_MMA(0, 0, At, B0); PG8_BAR; PG8_SCHED;
            PG8_LDB(B1, 0, 1); PG8_STAGE(PG8_SB(0, 0), b2, voffB);
            PG8_BAR; PG8_WAIT_L(0); PG8_MMA(0, 1, At, B1); PG8_BAR;
            PG8_LDA(At, 0, 1); PG8_STAGE(PG8_SA(0, 0), a2, voffA);
            PG8_BAR; PG8_WAIT_L(0); PG8_MMA(1, 0, At, B0); PG8_BAR; PG8_SCHED;
            PG8_STAGE(PG8_SB(0, 1), b2 + hstep, voffB);
            PG8_WAIT_V(6); PG8_BAR; PG8_MMA(1, 1, At, B1); PG8_BAR;
            PG8_LDB(B0, 1, 0); PG8_SCHED; PG8_LDA(At, 1, 0); PG8_STAGE(PG8_SA(0, 1), a2 + hstep, voffA);
            PG8_WAIT_L(8); PG8_BAR; PG8_WAIT_L(0); PG8_MMA(0, 0, At, B0); PG8_BAR; PG8_SCHED;
            PG8_LDB(B1, 1, 1); PG8_STAGE(PG8_SB(1, 0), b3, voffB);
            PG8_BAR; PG8_WAIT_L(0); PG8_MMA(0, 1, At, B1); PG8_BAR;
            PG8_LDA(At, 1, 1); PG8_STAGE(PG8_SA(1, 0), a3, voffA);
            PG8_BAR; PG8_WAIT_L(0); PG8_MMA(1, 0, At, B0); PG8_BAR; PG8_SCHED;
            PG8_STAGE(PG8_SB(1, 1), b3 + hstep, voffB);
            PG8_WAIT_V(6); PG8_BAR; PG8_MMA(1, 1, At, B1); PG8_BAR;
            }
        }
        if constexpr (ALIGN_EPI) { if (wr == 0) PG8_BAR; }
        if constexpr (!Epi::AFTER_DRAIN) { E(acc, cur, wr, wc, fr, fq); S.done(cur); }
        if (!has_next) break;
#pragma unroll
        for (int a = 0; a < 2; ++a)
#pragma unroll
            for (int b = 0; b < 2; ++b)
#pragma unroll
                for (int m = 0; m < 4; ++m)
#pragma unroll
                    for (int n = 0; n < 2; ++n) acc[a][b][m][n] = (f32x4){0.f, 0.f, 0.f, 0.f};
        cur = nxt; cA = nA; cB = nB; ++ui;
        if constexpr (ALIGN_EPI) { if (wr == 1) PG8_BAR; }
    }
    PG8_WAIT_V(0);
    if constexpr (!ALIGN_EPI) { if (wr == 0) PG8_BAR; }
    PG8_BAR;
    if constexpr (Epi::AFTER_DRAIN) { E.fused(acc, cur, wr, wc, fr, fq, lds, wid, lane); S.done(cur); }
#undef PG8_SA
#undef PG8_SB
#undef PG8_STAGE
#undef PG8_LDA
#undef PG8_LDB
#undef PG8_MMA
#undef PG8_WAIT_V
#undef PG8_WAIT_L
#undef PG8_BAR
#undef PG8_SCHED
}
}

using pg8::bf16_t; using pg8::bf16x8; using pg8::f32x4; using pg8::u32x4; using pg8::Unit;
#define LAS __attribute__((address_space(3)))
typedef unsigned u32x2 __attribute__((ext_vector_type(2)));
typedef float f32x2 __attribute__((ext_vector_type(2)));

constexpr int MTOK = 32768, DM = 1024, DFF = 2816, SEQ = 16384, NMEM = 256, DIN = 6144;
constexpr int NTHR = 512;
constexpr size_t MiB = 1024 * 1024;
constexpr size_t WS_W = 0;
constexpr size_t OW_GU1 = 0, OW_DN1 = OW_GU1 + (size_t)5632 * 1024 * 2, OW_IN = OW_DN1 + (size_t)1024 * 2816 * 2, OW_A = OW_IN + (size_t)6144 * 1024 * 2,
                 OW_B = OW_A + 2 * MiB, OW_OUT = OW_B + 2 * MiB, OW_Q = OW_OUT + 2 * MiB, OW_O = OW_Q + 2 * MiB, OW_KV = OW_O + 2 * MiB,
                 OW_GU2 = OW_KV + 4 * MiB, OW_DN2 = OW_GU2 + (size_t)5632 * 1024 * 2, OW_END = OW_DN2 + (size_t)1024 * 2816 * 2;
static_assert(OW_END <= 64 * MiB, "weights region");
constexpr size_t WS_HB = 64 * MiB;
constexpr size_t WS_R1 = 128 * MiB;
constexpr size_t SLOT = 64 * MiB;
constexpr size_t WS_SS = 448 * MiB;
constexpr size_t WS_VST = 450 * MiB;
constexpr size_t WS_KB = 454 * MiB;
constexpr size_t WS_VT = 455 * MiB;
constexpr size_t WS_MEMN = 456 * MiB;
constexpr size_t WS_END = 457 * MiB;
constexpr int LDS_BYTES = 256 * 528;

struct WDesc { const float* src; bf16_t* dst; const float* ksc; int K, Nsrc, Nout, mode; float csc; int pad; };
struct Params {
    const float* in[28]; float* out; unsigned char* ws;
    WDesc wd[11];
    int ph_lo, ph_hi;
};

__device__ __forceinline__ unsigned pk2(float lo, float hi) { unsigned r; asm volatile("v_cvt_pk_bf16_f32 %0, %1, %2" : "=v"(r) : "v"(lo), "v"(hi)); return r; }
__device__ __forceinline__ float bflo(unsigned w) { return __uint_as_float(w << 16); }
__device__ __forceinline__ float bfhi(unsigned w) { return __uint_as_float(w & 0xffff0000u); }
__device__ __forceinline__ float fsigmoid(float x) { return __builtin_amdgcn_rcpf(1.0f + __expf(-x)); }
__device__ __forceinline__ float fsilu(float x) { return x * fsigmoid(x); }
__device__ __forceinline__ float fgelu(float x) { return x * fsigmoid(1.5957691216057308f * (x + 0.044715f * x * x * x)); }
__device__ __forceinline__ float row_rs(const float* ss, int row) {
    const f32x4* p = (const f32x4*)(ss + (size_t)row * 16);
    const f32x4 a = p[0], b = p[1], c = p[2], d = p[3];
    const float s = ((a[0] + a[1]) + (a[2] + a[3])) + ((b[0] + b[1]) + (b[2] + b[3])) + ((c[0] + c[1]) + (c[2] + c[3])) + ((d[0] + d[1]) + (d[2] + d[3]));
    return rsqrtf(s * (1.0f / 1024.0f) + 1e-6f);
}
__device__ __forceinline__ float xor16_32_sum(float v) { v += __shfl_xor(v, 16); v += __shfl_xor(v, 32); return v; }

struct EpiSwiglu {
    static constexpr bool PERM = true, AFTER_DRAIN = false;
    bf16_t* out; const float* ss;
    __device__ __forceinline__ void operator()(const f32x4 (&acc)[2][2][4][2], const Unit& u, int wr, int wc, int fr, int fq) const {
        const int row0 = u.pm * 256 + wr * 64 + fr, col0 = u.pn * 128 + wc * 32 + 8 * fq;
#pragma unroll
        for (int ai = 0; ai < 2; ++ai)
#pragma unroll
            for (int m = 0; m < 4; ++m) {
                const int row = row0 + ai * 128 + m * 16; const float r = row_rs(ss, row);
                u32x4 w;
#pragma unroll
                for (int n = 0; n < 2; ++n)
#pragma unroll
                    for (int jj = 0; jj < 2; ++jj) {
                        const float g0 = r * acc[ai][0][m][n][2 * jj], g1 = r * acc[ai][0][m][n][2 * jj + 1];
                        const float u0 = r * acc[ai][1][m][n][2 * jj], u1 = r * acc[ai][1][m][n][2 * jj + 1];
                        w[n * 2 + jj] = pk2(fsilu(g0) * u0, fsilu(g1) * u1);
                    }
                *(u32x4*)(out + (size_t)row * DFF + col0) = w;
            }
    }
};
struct EpiRes {
    static constexpr bool PERM = true, AFTER_DRAIN = false;
    const float* hin; float* hout; bf16_t* hb; float* ss; float scale;
    __device__ __forceinline__ void operator()(const f32x4 (&acc)[2][2][4][2], const Unit& u, int wr, int wc, int fr, int fq) const {
        const int row0 = u.pm * 256 + wr * 64 + fr, col0 = u.pn * 256 + wc * 32 + 8 * fq;
#pragma unroll
        for (int ai = 0; ai < 2; ++ai)
#pragma unroll
            for (int m = 0; m < 4; ++m) {
                const int row = row0 + ai * 128 + m * 16; float sq = 0.f;
#pragma unroll
                for (int bj = 0; bj < 2; ++bj) {
                    const size_t o = (size_t)row * DM + col0 + bj * 128;
                    const f32x4 x0 = *(const f32x4*)(hin + o), x1 = *(const f32x4*)(hin + o + 4);
                    const f32x4 v0 = x0 + scale * acc[ai][bj][m][0], v1 = x1 + scale * acc[ai][bj][m][1];
                    *(f32x4*)(hout + o) = v0; *(f32x4*)(hout + o + 4) = v1;
                    sq += (v0[0] * v0[0] + v0[1] * v0[1]) + (v0[2] * v0[2] + v0[3] * v0[3]) + (v1[0] * v1[0] + v1[1] * v1[1]) + (v1[2] * v1[2] + v1[3] * v1[3]);
                    if (hb) { u32x4 w; w[0] = pk2(v0[0], v0[1]); w[1] = pk2(v0[2], v0[3]); w[2] = pk2(v1[0], v1[1]); w[3] = pk2(v1[2], v1[3]); *(u32x4*)(hb + o) = w; }
                }
                sq = xor16_32_sum(sq);
                if (fq == 0) ss[(size_t)row * 16 + u.pn * 4 + wc] = sq;
            }
    }
};
struct EpiWin {
    static constexpr bool PERM = true, AFTER_DRAIN = false;
    const float* ss; const float* bias; bf16_t* a_out; bf16_t* g_out; float* vst;
    __device__ __forceinline__ void operator()(const f32x4 (&acc)[2][2][4][2], const Unit& u, int wr, int wc, int fr, int fq) const {
        const int row0 = u.pm * 256 + wr * 64 + fr; const int pn = u.pn;
        if (pn < 8) {
            const int col0 = pn * 128 + wc * 32 + 8 * fq;
            const f32x4 bv0 = *(const f32x4*)(bias + col0), bv1 = *(const f32x4*)(bias + col0 + 4), bg0 = *(const f32x4*)(bias + 1024 + col0), bg1 = *(const f32x4*)(bias + 1024 + col0 + 4);
#pragma unroll
            for (int ai = 0; ai < 2; ++ai)
#pragma unroll
                for (int m = 0; m < 4; ++m) {
                    const int row = row0 + ai * 128 + m * 16; const float r = row_rs(ss, row);
                    const f32x4 v0 = r * acc[ai][0][m][0] + bv0, v1 = r * acc[ai][0][m][1] + bv1, g0 = r * acc[ai][1][m][0] + bg0, g1 = r * acc[ai][1][m][1] + bg1;
                    u32x4 w;
                    w[0] = pk2(v0[0] * fsigmoid(g0[0]), v0[1] * fsigmoid(g0[1])); w[1] = pk2(v0[2] * fsigmoid(g0[2]), v0[3] * fsigmoid(g0[3]));
                    w[2] = pk2(v1[0] * fsigmoid(g1[0]), v1[1] * fsigmoid(g1[1])); w[3] = pk2(v1[2] * fsigmoid(g1[2]), v1[3] * fsigmoid(g1[3]));
                    *(u32x4*)(a_out + (size_t)row * DM + col0) = w;
                }
        } else {
            const int idx = (pn - 8) >> 2; const int cb = ((pn - 8) & 3) * 256 + wc * 32 + 8 * fq;
            bf16_t* ob = g_out + (size_t)idx * MTOK * DM;
            f32x4 b[2][2];
#pragma unroll
            for (int bj = 0; bj < 2; ++bj) { b[bj][0] = *(const f32x4*)(bias + 2048 + idx * 1024 + cb + bj * 128); b[bj][1] = *(const f32x4*)(bias + 2048 + idx * 1024 + cb + bj * 128 + 4); }
#pragma unroll
            for (int ai = 0; ai < 2; ++ai)
#pragma unroll
                for (int m = 0; m < 4; ++m) {
                    const int row = row0 + ai * 128 + m * 16; const float r = row_rs(ss, row);
                    float s1 = 0.f, s2 = 0.f;
#pragma unroll
                    for (int bj = 0; bj < 2; ++bj) {
                        f32x4 v0 = r * acc[ai][bj][m][0] + b[bj][0], v1 = r * acc[ai][bj][m][1] + b[bj][1];
                        if (idx < 2) {
#pragma unroll
                            for (int j = 0; j < 4; ++j) { v0[j] = fgelu(v0[j]); v1[j] = fgelu(v1[j]); }
                        } else {
#pragma unroll
                            for (int j = 0; j < 4; ++j) { v0[j] = fsigmoid(v0[j]); v1[j] = fsigmoid(v1[j]); }
                        }
                        s1 += (v0[0] + v0[1]) + (v0[2] + v0[3]) + (v1[0] + v1[1]) + (v1[2] + v1[3]);
                        s2 += (v0[0] * v0[0] + v0[1] * v0[1]) + (v0[2] * v0[2] + v0[3] * v0[3]) + (v1[0] * v1[0] + v1[1] * v1[1]) + (v1[2] * v1[2] + v1[3] * v1[3]);
                        u32x4 w; w[0] = pk2(v0[0], v0[1]); w[1] = pk2(v0[2], v0[3]); w[2] = pk2(v1[0], v1[1]); w[3] = pk2(v1[2], v1[3]);
                        *(u32x4*)(ob + (size_t)row * DM + cb + bj * 128) = w;
                    }
                    if (idx == 1) {
                        s1 = xor16_32_sum(s1); s2 = xor16_32_sum(s2);
                        if (fq == 0) { f32x2 st; st[0] = s1; st[1] = s2; *(f32x2*)(vst + ((size_t)row * 16 + (pn - 12) * 4 + wc) * 2) = st; }
                    }
                }
        }
    }
};
template <int MODE> struct EpiGate {
    static constexpr bool PERM = true, AFTER_DRAIN = false;
    const bf16_t* sg; float* ya; bf16_t* ob; const float* ss;
    __device__ __forceinline__ void operator()(const f32x4 (&acc)[2][2][4][2], const Unit& u, int wr, int wc, int fr, int fq) const {
        const int row0 = u.pm * 256 + wr * 64 + fr, col0 = u.pn * 256 + wc * 32 + 8 * fq;
#pragma unroll
        for (int ai = 0; ai < 2; ++ai)
#pragma unroll
            for (int m = 0; m < 4; ++m) {
                const int row = row0 + ai * 128 + m * 16;
                float r = 1.f; if (MODE == 2) r = row_rs(ss, row);
#pragma unroll
                for (int bj = 0; bj < 2; ++bj) {
                    const size_t o = (size_t)row * DM + col0 + bj * 128;
                    f32x4 v0, v1;
                    if (MODE == 2) { v0 = r * acc[ai][bj][m][0]; v1 = r * acc[ai][bj][m][1]; }
                    else {
                        const u32x4 g = *(const u32x4*)(sg + o);
                        f32x4 s0, s1; s0[0] = bflo(g[0]); s0[1] = bfhi(g[0]); s0[2] = bflo(g[1]); s0[3] = bfhi(g[1]); s1[0] = bflo(g[2]); s1[1] = bfhi(g[2]); s1[2] = bflo(g[3]); s1[3] = bfhi(g[3]);
                        v0 = s0 * acc[ai][bj][m][0]; v1 = s1 * acc[ai][bj][m][1];
                        if (MODE == 1) { v0 += *(const f32x4*)(ya + o); v1 += *(const f32x4*)(ya + o + 4); }
                    }
                    if (MODE == 0) { *(f32x4*)(ya + o) = v0; *(f32x4*)(ya + o + 4) = v1; }
                    else { u32x4 w; w[0] = pk2(v0[0], v0[1]); w[1] = pk2(v0[2], v0[3]); w[2] = pk2(v1[0], v1[1]); w[3] = pk2(v1[2], v1[3]); *(u32x4*)(ob + o) = w; }
                }
            }
    }
};
__device__ __forceinline__ int vpos(int m) { return (m & ~31) | (((m >> 2) & 3) << 3) | (((m >> 4) & 1) << 2) | (m & 3); }
__device__ __forceinline__ int wmap(int mode, int n) {
    if (mode == 1) { const int p = n >> 8, bj = (n >> 7) & 1, c = n & 127; return bj * DFF + p * 128 + c; }
    if (mode == 2) { const int p = n >> 8; if (p < 8) { const int bj = (n >> 7) & 1, c = n & 127; return bj * 1024 + p * 128 + c; } return n; }
    return n;
}
__device__ void prep_phase(unsigned char* lds_g, const Params& P) {
    float* tile = (float*)lds_g;
    const int tid = threadIdx.x, G = gridDim.x;
    for (int d = 0; d < 11; ++d) {
        const WDesc w = P.wd[d];
        const int nkt = w.K / 64, ntl = nkt * (w.Nout / 64);
        for (int t = blockIdx.x; t < ntl; t += G) {
            const int kt = t % nkt, nb = t / nkt, k0 = kt * 64, n0 = nb * 64;
            const int sc0 = wmap(w.mode, n0);
            const int tk = tid >> 4, tn = (tid & 15) * 4;
#pragma unroll
            for (int i = 0; i < 2; ++i) {
                const int k = k0 + tk + 32 * i;
                f32x4 v = *(const f32x4*)(w.src + (size_t)k * w.Nsrc + sc0 + tn);
                const float sc = w.csc * (w.ksc ? w.ksc[k] : 1.0f);
                float* tp = tile + (tk + 32 * i) * 65 + tn;
                tp[0] = v[0] * sc; tp[1] = v[1] * sc; tp[2] = v[2] * sc; tp[3] = v[3] * sc;
            }
            __syncthreads();
            const int n = tid >> 3, kq = (tid & 7) * 8;
            u32x4 o;
#pragma unroll
            for (int e = 0; e < 4; ++e) o[e] = pk2(tile[(kq + 2 * e) * 65 + n], tile[(kq + 2 * e + 1) * 65 + n]);
            *(u32x4*)(w.dst + (size_t)(n0 + n) * w.K + k0 + kq) = o;
            __syncthreads();
        }
    }
    const int lane = tid & 63, gw = blockIdx.x * 8 + (tid >> 6), nw = G * 8;
    const float* x = P.in[0]; bf16_t* xb = (bf16_t*)(P.ws + WS_HB); float* ss = (float*)(P.ws + WS_SS);
    for (int row = gw; row < MTOK; row += nw) {
        float sq = 0.f;
#pragma unroll
        for (int i = 0; i < 4; ++i) {
            const f32x4 v = *(const f32x4*)(x + (size_t)row * DM + i * 256 + lane * 4);
            sq += (v[0] * v[0] + v[1] * v[1]) + (v[2] * v[2] + v[3] * v[3]);
            u32x2 o; o[0] = pk2(v[0], v[1]); o[1] = pk2(v[2], v[3]);
            *(u32x2*)(xb + (size_t)row * DM + i * 256 + lane * 4) = o;
        }
#pragma unroll
        for (int s = 1; s < 64; s <<= 1) sq += __shfl_xor(sq, s);
        if (lane < 16) ss[(size_t)row * 16 + lane] = lane == 0 ? sq : 0.f;
    }
    const float* mem = P.in[1]; const float* mg = P.in[20]; bf16_t* memn = (bf16_t*)(P.ws + WS_MEMN);
    for (int row = gw; row < 2 * NMEM; row += nw) {
        f32x4 v[4]; float sq = 0.f;
#pragma unroll
        for (int i = 0; i < 4; ++i) { v[i] = *(const f32x4*)(mem + (size_t)row * DM + i * 256 + lane * 4); sq += (v[i][0] * v[i][0] + v[i][1] * v[i][1]) + (v[i][2] * v[i][2] + v[i][3] * v[i][3]); }
#pragma unroll
        for (int s = 1; s < 64; s <<= 1) sq += __shfl_xor(sq, s);
        const float r = rsqrtf(sq * (1.0f / 1024.0f) + 1e-6f);
#pragma unroll
        for (int i = 0; i < 4; ++i) {
            const f32x4 g = *(const f32x4*)(mg + i * 256 + lane * 4);
            u32x2 o; o[0] = pk2(v[i][0] * r * g[0], v[i][1] * r * g[1]); o[1] = pk2(v[i][2] * r * g[2], v[i][3] * r * g[3]);
            *(u32x2*)(memn + (size_t)row * DM + i * 256 + lane * 4) = o;
        }
    }
}


__device__ void kv_phase(unsigned char* lds_g, const Params& P) {
    LAS float* red = (LAS float*)lds_g;
    const int tid = threadIdx.x, lane = tid & 63, wave = tid >> 6, fr = lane & 15, fq = lane >> 4;
    const bf16_t* memn = (const bf16_t*)(P.ws + WS_MEMN); const bf16_t* Wt = (const bf16_t*)(P.ws + WS_W + OW_KV);
    bf16_t* Kb = (bf16_t*)(P.ws + WS_KB); bf16_t* Vt = (bf16_t*)(P.ws + WS_VT);
    for (int tile = blockIdx.x; tile < 256; tile += gridDim.x) {
        const int tm = tile >> 5, tn = tile & 31;
        f32x4 acc[4][4];
#pragma unroll
        for (int i = 0; i < 4; ++i)
#pragma unroll
            for (int j = 0; j < 4; ++j) acc[i][j] = (f32x4){0.f, 0.f, 0.f, 0.f};
#pragma unroll
        for (int ks = 0; ks < 4; ++ks) {
            const int k = wave * 128 + ks * 32 + fq * 8;
            bf16x8 af[4], bf[4];
#pragma unroll
            for (int i = 0; i < 4; ++i) { af[i] = *(const bf16x8*)(memn + (size_t)(64 * tm + 16 * i + fr) * DM + k); bf[i] = *(const bf16x8*)(Wt + (size_t)(64 * tn + 16 * i + fr) * DM + k); }
#pragma unroll
            for (int mb = 0; mb < 4; ++mb)
#pragma unroll
                for (int nb = 0; nb < 4; ++nb) acc[mb][nb] = __builtin_amdgcn_mfma_f32_16x16x32_bf16(bf[nb], af[mb], acc[mb][nb], 0, 0, 0);
        }
        __syncthreads();
#pragma unroll
        for (int mb = 0; mb < 4; ++mb)
#pragma unroll
            for (int nb = 0; nb < 4; ++nb) *(LAS f32x4*)(red + (wave * 64 + 16 * mb + fr) * 64 + 16 * nb + 4 * fq) = acc[mb][nb];
        __syncthreads();
        const int b = tm >> 2, mbase = (tm & 3) * 64, col = (tn & 15) * 64, h = col >> 8, d0 = col & 255;
        float v[8];
#pragma unroll
        for (int j = 0; j < 8; ++j) v[j] = 0.f;
        if (tn < 16) {
            const int m = tid >> 3, n8 = (tid & 7) * 8;
#pragma unroll
            for (int w = 0; w < 8; ++w) { const f32x4 x0 = *(const LAS f32x4*)(red + (w * 64 + m) * 64 + n8), x1 = *(const LAS f32x4*)(red + (w * 64 + m) * 64 + n8 + 4);
#pragma unroll
                for (int j = 0; j < 4; ++j) { v[j] += x0[j]; v[4 + j] += x1[j]; } }
            u32x4 o; o[0] = pk2(v[0], v[1]); o[1] = pk2(v[2], v[3]); o[2] = pk2(v[4], v[5]); o[3] = pk2(v[6], v[7]);
            *(u32x4*)(Kb + ((size_t)(b * 4 + h) * 256 + mbase + m) * 256 + d0 + n8) = o;
        } else {
            const int n = tid >> 3, p8 = (tid & 7) * 8;
#pragma unroll
            for (int e = 0; e < 8; ++e) {
                const int pp = p8 + e, key = (pp & 32) | (((pp >> 2) & 1) << 4) | (((pp >> 3) & 3) << 2) | (pp & 3);
#pragma unroll
                for (int w = 0; w < 8; ++w) v[e] += red[(w * 64 + key) * 64 + n];
            }
            u32x4 o; o[0] = pk2(v[0], v[1]); o[1] = pk2(v[2], v[3]); o[2] = pk2(v[4], v[5]); o[3] = pk2(v[6], v[7]);
            *(u32x4*)(Vt + ((size_t)(b * 4 + h) * 256 + d0 + n) * 256 + mbase + p8) = o;
        }
    }
    __syncthreads();
}

__device__ void final_phase(const Params& P) {
    const int tid = threadIdx.x, lane = tid & 63, gw = blockIdx.x * 8 + (tid >> 6), nw = gridDim.x * 8;
    float* h = P.out; const float* ss = (const float*)(P.ws + WS_SS); const float* g = P.in[27];
    f32x4 gg[4];
#pragma unroll
    for (int i = 0; i < 4; ++i) gg[i] = *(const f32x4*)(g + i * 256 + lane * 4);
    for (int row = gw; row < MTOK; row += nw) {
        const float r = row_rs(ss, row);
#pragma unroll
        for (int i = 0; i < 4; ++i) {
            float* p = h + (size_t)row * DM + i * 256 + lane * 4;
            f32x4 v = *(const f32x4*)p; v = v * r * gg[i]; *(f32x4*)p = v;
        }
    }
}

template <int N> __device__ __forceinline__ void bfly(float (&v)[64], int lane) {
    const bool hi = (lane & N) != 0;
#pragma unroll
    for (int k = 0; k < N; ++k) { const float send = hi ? v[k] : v[k + N]; const float keep = hi ? v[k + N] : v[k]; v[k] = keep + __shfl_xor(send, N); }
}
constexpr int CT = 32, CROWS = CT + 30;
template <int S> __device__ __forceinline__ void conv_row(f32x2 (&acc)[CT], const f32x2 (&w)[31], const LAS unsigned char* lp) {
    const unsigned wv = *(const LAS unsigned*)(lp + S * 2048);
    f32x2 av; av[0] = bflo(wv); av[1] = bfhi(wv);
#pragma unroll
    for (int t = 0; t < CT; ++t) { if (S - t >= 0 && S - t <= 30) acc[t] += w[(S - t >= 0 && S - t <= 30) ? S - t : 0] * av; }
}
template <int... S> __device__ __forceinline__ void conv_all(f32x2 (&acc)[CT], const f32x2 (&w)[31], const LAS unsigned char* lp, std::integer_sequence<int, S...>) { (conv_row<S>(acc, w, lp), ...); }
__device__ void conv_phase(unsigned char* lds_g, const Params& P) {
    LAS unsigned char* lds = (LAS unsigned char*)lds_g;
    LAS float* red = (LAS float*)(lds + CROWS * 2048); LAS float* stat = red + 512;
    const int tid = threadIdx.x, lane = tid & 63, wave = tid >> 6, G = gridDim.x;
    const bf16_t* a = (const bf16_t*)(P.ws + WS_R1); bf16_t* ac = (bf16_t*)(P.ws + WS_HB);
    const float* cw = P.in[8];
    f32x2 w[31];
#pragma unroll
    for (int j = 0; j < 31; ++j) w[j] = *(const f32x2*)(cw + j * 1024 + 2 * tid);
    const f32x2 cb = *(const f32x2*)(P.in[9] + 2 * tid), lg = *(const f32x2*)(P.in[10] + 2 * tid), lb = *(const f32x2*)(P.in[11] + 2 * tid);
    for (int tile = blockIdx.x; tile < MTOK / CT; tile += G) {
        const int t0 = tile * CT, tin = t0 & (SEQ - 1);
        for (int c = tid; c < CROWS * 128; c += NTHR) {
            const int r = c >> 7, cc = c & 127;
            u32x4 v = {0u, 0u, 0u, 0u};
            if (tin - 30 + r >= 0) v = *(const u32x4*)(a + (size_t)(t0 - 30 + r) * DM + cc * 8);
            *(LAS u32x4*)(lds + r * 2048 + cc * 16) = v;
        }
        __syncthreads();
        f32x2 acc[CT];
#pragma unroll
        for (int t = 0; t < CT; ++t) acc[t] = cb;
        conv_all(acc, w, lds + tid * 4, std::make_integer_sequence<int, CROWS>{});
        float v[64];
#pragma unroll
        for (int t = 0; t < CT; ++t) { v[t] = acc[t][0] + acc[t][1]; v[32 + t] = acc[t][0] * acc[t][0] + acc[t][1] * acc[t][1]; }
        bfly<32>(v, lane); bfly<16>(v, lane); bfly<8>(v, lane); bfly<4>(v, lane); bfly<2>(v, lane); bfly<1>(v, lane);
        red[wave * 64 + lane] = v[0];
        __syncthreads();
        if (tid < 64) { float s = 0.f;
#pragma unroll
            for (int q = 0; q < 8; ++q) s += red[q * 64 + tid];
            stat[tid] = s; }
        __syncthreads();
#pragma unroll
        for (int t = 0; t < CT; ++t) {
            const float mean = stat[t] * (1.0f / 1024.0f), var = stat[32 + t] * (1.0f / 1024.0f) - mean * mean, rstd = rsqrtf(var + 1e-5f);
            const float y0 = (acc[t][0] - mean) * rstd * lg[0] + lb[0], y1 = (acc[t][1] - mean) * rstd * lg[1] + lb[1];
            *(unsigned*)(ac + (size_t)(t0 + t) * DM + 2 * tid) = pk2(fsilu(y0), fsilu(y1));
        }
    }
    __syncthreads();
}

__device__ void sgu_phase(unsigned char* lds_g, const Params& P) {
    LAS unsigned char* lds = (LAS unsigned char*)lds_g;
    LAS unsigned char* Wl = lds;
    LAS unsigned char* Vl = lds + 128 * 272;
    LAS float* stat = (LAS float*)(lds + 128 * 272 + 128 * 520);
    const int tid = threadIdx.x, lane = tid & 63, wave = tid >> 6, fr = lane & 15, fq = lane >> 4, G = gridDim.x;
    const bf16_t* gu = (const bf16_t*)(P.ws + WS_R1 + SLOT); const bf16_t* gv = (const bf16_t*)(P.ws + WS_R1 + 2 * SLOT);
    bf16_t* sb = (bf16_t*)(P.ws + WS_R1);
    const float* vst = (const float*)(P.ws + WS_VST);
    const float* lng = P.in[13]; const float* lnb = P.in[14]; const float* sw = P.in[15]; const float* sbias = P.in[16];
    int lastg = -1;
    for (int u = blockIdx.x; u < 1024; u += G) {
        const int c = u >> 2, g = u & 3;
        __syncthreads();
        if (g != lastg) {
            lastg = g;
#pragma unroll
            for (int i = 0; i < 4; ++i) {
                const int e = tid + NTHR * i, t = e >> 4, s8 = (e & 15) * 8;
                const float* sp = sw + ((size_t)g * 128 + t) * 128 + s8;
                const f32x4 x0 = *(const f32x4*)sp, x1 = *(const f32x4*)(sp + 4);
                float f[8] = {x0[0], x0[1], x0[2], x0[3], x1[0], x1[1], x1[2], x1[3]};
#pragma unroll
                for (int j = 0; j < 8; ++j) if (s8 + j > t) f[j] = 0.f;
                u32x4 o; o[0] = pk2(f[0], f[1]); o[1] = pk2(f[2], f[3]); o[2] = pk2(f[4], f[5]); o[3] = pk2(f[6], f[7]);
                *(LAS u32x4*)(Wl + t * 272 + s8 * 2) = o;
            }
        }
        if (tid < 128) {
            const f32x4* p = (const f32x4*)(vst + (size_t)(c * 128 + tid) * 32);
            float s1 = 0.f, s2 = 0.f;
#pragma unroll
            for (int q = 0; q < 8; ++q) { const f32x4 x = p[q]; s1 += x[0] + x[2]; s2 += x[1] + x[3]; }
            const float mean = s1 * (1.0f / 1024.0f), var = s2 * (1.0f / 1024.0f) - mean * mean;
            stat[tid * 2] = mean; stat[tid * 2 + 1] = rsqrtf(var + 1e-5f);
        }
        __syncthreads();
#pragma unroll
        for (int i = 0; i < 8; ++i) {
            const int e = tid + NTHR * i, s = e >> 5, c8 = (e & 31) * 8;
            const u32x4 raw = *(const u32x4*)(gv + (size_t)(c * 128 + s) * DM + g * 256 + c8);
            const float mean = stat[s * 2], rstd = stat[s * 2 + 1];
            const f32x4 g0 = *(const f32x4*)(lng + g * 256 + c8), g1 = *(const f32x4*)(lng + g * 256 + c8 + 4), b0 = *(const f32x4*)(lnb + g * 256 + c8), b1 = *(const f32x4*)(lnb + g * 256 + c8 + 4);
            float f[8] = {bflo(raw[0]), bfhi(raw[0]), bflo(raw[1]), bfhi(raw[1]), bflo(raw[2]), bfhi(raw[2]), bflo(raw[3]), bfhi(raw[3])};
#pragma unroll
            for (int j = 0; j < 4; ++j) { f[j] = (f[j] - mean) * rstd * g0[j] + b0[j]; f[4 + j] = (f[4 + j] - mean) * rstd * g1[j] + b1[j]; }
            u32x2 o0, o1; o0[0] = pk2(f[0], f[1]); o0[1] = pk2(f[2], f[3]); o1[0] = pk2(f[4], f[5]); o1[1] = pk2(f[6], f[7]);
            *(LAS u32x2*)(Vl + s * 520 + c8 * 2) = o0; *(LAS u32x2*)(Vl + s * 520 + c8 * 2 + 8) = o1;
        }
        __syncthreads();
        f32x4 acc[2][8];
#pragma unroll
        for (int db = 0; db < 2; ++db)
#pragma unroll
            for (int tb = 0; tb < 8; ++tb) acc[db][tb] = (f32x4){0.f, 0.f, 0.f, 0.f};
#pragma unroll
        for (int ks = 0; ks < 4; ++ks) {
            bf16x8 vf[2];
#pragma unroll
            for (int db = 0; db < 2; ++db)
#pragma unroll
                for (int e = 0; e < 8; ++e) vf[db][e] = *(const LAS short*)(Vl + (32 * ks + 8 * fq + e) * 520 + (32 * wave + 16 * db + fr) * 2);
#pragma unroll
            for (int tb = 0; tb < 8; ++tb) {
                if (16 * tb + 15 >= 32 * ks) {
                    const bf16x8 wf = *(const LAS bf16x8*)(Wl + (16 * tb + fr) * 272 + (32 * ks + 8 * fq) * 2);
#pragma unroll
                    for (int db = 0; db < 2; ++db) acc[db][tb] = __builtin_amdgcn_mfma_f32_16x16x32_bf16(vf[db], wf, acc[db][tb], 0, 0, 0);
                }
            }
        }
#pragma unroll
        for (int tb = 0; tb < 8; ++tb) {
            const int t = 16 * tb + fr; const size_t row = (size_t)c * 128 + t; const float bias = sbias[g * 128 + t];
#pragma unroll
            for (int db = 0; db < 2; ++db) {
                const size_t o = row * DM + g * 256 + 32 * wave + 16 * db + 4 * fq;
                const u32x2 uu = *(const u32x2*)(gu + o);
                u32x2 w; w[0] = pk2(bflo(uu[0]) * (acc[db][tb][0] + bias), bfhi(uu[0]) * (acc[db][tb][1] + bias)); w[1] = pk2(bflo(uu[1]) * (acc[db][tb][2] + bias), bfhi(uu[1]) * (acc[db][tb][3] + bias));
                *(u32x2*)(sb + o) = w;
            }
        }
    }
    __syncthreads();
}

__device__ void attn_phase(unsigned char* lds_g, const Params& P) {
    LAS unsigned char* lds = (LAS unsigned char*)lds_g;
    const int tid = threadIdx.x, lane = tid & 63, wave = tid >> 6, fr = lane & 15, fq = lane >> 4, G = gridDim.x;
    const bf16_t* q = (const bf16_t*)(P.ws + WS_R1 + 3 * SLOT); bf16_t* o = (bf16_t*)(P.ws + WS_R1 + 4 * SLOT);
    const bf16_t* Kb = (const bf16_t*)(P.ws + WS_KB); const bf16_t* Vt = (const bf16_t*)(P.ws + WS_VT);
    for (int u = blockIdx.x; u < 512; u += G) {
        const int bh = u >> 6, qb = u & 63, b = bh >> 2, h = bh & 3;
        const size_t rowq = (size_t)b * SEQ + qb * 256 + wave * 32 + fr;
        __syncthreads();
#pragma unroll
        for (int i = 0; i < 16; ++i) {
            const int e = tid + NTHR * i, r = e >> 5, cc = e & 31;
            *(LAS u32x4*)(lds + r * 528 + cc * 16) = *(const u32x4*)(Kb + ((size_t)bh * 256 + r) * 256 + cc * 8);
        }
        const bf16_t* qp = q + rowq * DM + h * 256 + fq * 8;
        bf16x8 qn0 = *(const bf16x8*)qp, qn1 = *(const bf16x8*)(qp + 16 * DM);
        __syncthreads();
        f32x4 S[16][2];
#pragma unroll
        for (int kb = 0; kb < 16; ++kb) { S[kb][0] = (f32x4){0.f, 0.f, 0.f, 0.f}; S[kb][1] = (f32x4){0.f, 0.f, 0.f, 0.f}; }
#pragma unroll 1
        for (int ks = 0; ks < 8; ++ks) {
            const bf16x8 q0 = qn0, q1 = qn1;
            const int kn = ks < 7 ? ks + 1 : 7;
            qn0 = *(const bf16x8*)(qp + kn * 32); qn1 = *(const bf16x8*)(qp + 16 * DM + kn * 32);
            const LAS unsigned char* kp = lds + fr * 528 + (32 * ks + 8 * fq) * 2;
#pragma unroll
            for (int kb = 0; kb < 16; ++kb) {
                const bf16x8 kf = *(const LAS bf16x8*)(kp + kb * 16 * 528);
                S[kb][0] = __builtin_amdgcn_mfma_f32_16x16x32_bf16(kf, q0, S[kb][0], 0, 0, 0);
                S[kb][1] = __builtin_amdgcn_mfma_f32_16x16x32_bf16(kf, q1, S[kb][1], 0, 0, 0);
                if ((kb & 3) == 3) __builtin_amdgcn_sched_barrier(0);
            }
        }
        float inv[2];
#pragma unroll
        for (int nb = 0; nb < 2; ++nb) {
            float mx = -3.0e38f;
#pragma unroll
            for (int kb = 0; kb < 16; ++kb) mx = fmaxf(fmaxf(fmaxf(S[kb][nb][0], S[kb][nb][1]), fmaxf(S[kb][nb][2], S[kb][nb][3])), mx);
            mx = fmaxf(mx, __shfl_xor(mx, 16)); mx = fmaxf(mx, __shfl_xor(mx, 32));
            float sum = 0.f;
#pragma unroll
            for (int kb = 0; kb < 16; ++kb)
#pragma unroll
                for (int j = 0; j < 4; ++j) { const float p = __expf(S[kb][nb][j] - mx); S[kb][nb][j] = p; sum += p; }
            sum = xor16_32_sum(sum);
            inv[nb] = 1.0f / sum;
        }
        bf16x8 pf[8][2];
#pragma unroll
        for (int c = 0; c < 8; ++c)
#pragma unroll
            for (int nb = 0; nb < 2; ++nb) {
                u32x4 w; w[0] = pk2(S[2 * c][nb][0], S[2 * c][nb][1]); w[1] = pk2(S[2 * c][nb][2], S[2 * c][nb][3]); w[2] = pk2(S[2 * c + 1][nb][0], S[2 * c + 1][nb][1]); w[3] = pk2(S[2 * c + 1][nb][2], S[2 * c + 1][nb][3]);
                pf[c][nb] = __builtin_bit_cast(bf16x8, w);
            }
        __syncthreads();
        __builtin_amdgcn_sched_barrier(0);
#pragma unroll
        for (int i = 0; i < 16; ++i) {
            const int e = tid + NTHR * i, r = e >> 5, cc = e & 31;
            *(LAS u32x4*)(lds + r * 528 + cc * 16) = *(const u32x4*)(Vt + ((size_t)bh * 256 + r) * 256 + cc * 8);
        }
        __syncthreads();
#pragma unroll 1
        for (int dq = 0; dq < 4; ++dq) {
            const LAS unsigned char* vp = lds + (64 * dq + fr) * 528 + 16 * fq;
            f32x4 O[4][2];
#pragma unroll
            for (int db = 0; db < 4; ++db) { O[db][0] = (f32x4){0.f, 0.f, 0.f, 0.f}; O[db][1] = (f32x4){0.f, 0.f, 0.f, 0.f}; }
#pragma unroll
            for (int db = 0; db < 4; ++db)
#pragma unroll
                for (int c = 0; c < 8; ++c) {
                    const bf16x8 vf = *(const LAS bf16x8*)(vp + db * 16 * 528 + c * 64);
                    O[db][0] = __builtin_amdgcn_mfma_f32_16x16x32_bf16(vf, pf[c][0], O[db][0], 0, 0, 0);
                    O[db][1] = __builtin_amdgcn_mfma_f32_16x16x32_bf16(vf, pf[c][1], O[db][1], 0, 0, 0);
                }
#pragma unroll
            for (int nb = 0; nb < 2; ++nb)
#pragma unroll
                for (int db = 0; db < 4; ++db) {
                    u32x2 w; w[0] = pk2(O[db][nb][0] * inv[nb], O[db][nb][1] * inv[nb]); w[1] = pk2(O[db][nb][2] * inv[nb], O[db][nb][3] * inv[nb]);
                    *(u32x2*)(o + (rowq + nb * 16) * DM + h * 256 + 64 * dq + 16 * db + 4 * fq) = w;
                }
        }
    }
    __syncthreads();
}

template <class Epi> __device__ __forceinline__ void run_gemm(unsigned char* lds, const bf16_t* A, const bf16_t* Bt, int M, int N, int K, const Epi& E) {
    pg8::Gemm g{A, Bt, M, N, K}; pg8::StaticOrder S; S.init(M, N, (int)gridDim.x, (int)blockIdx.x);
    pg8::gemm_phase<Epi, pg8::StaticOrder, true, true>((PG8_LAS unsigned char*)lds, g, S, E);
}

__global__ void __launch_bounds__(NTHR, 2) mega_fwd(Params P) {
    extern __shared__ __attribute__((aligned(16))) unsigned char lds[];
    cg::grid_group grid = cg::this_grid();
    const int lo = P.ph_lo, hi = P.ph_hi;
    unsigned char* ws = P.ws;
    bf16_t* W = (bf16_t*)(ws + WS_W);
    bf16_t* HB = (bf16_t*)(ws + WS_HB);
    bf16_t* S0 = (bf16_t*)(ws + WS_R1), *S1 = (bf16_t*)(ws + WS_R1 + SLOT), *S3 = (bf16_t*)(ws + WS_R1 + 3 * SLOT), *S4 = (bf16_t*)(ws + WS_R1 + 4 * SLOT);
    float* YA = (float*)(ws + WS_R1 + SLOT);
    float* SS = (float*)(ws + WS_SS); float* VST = (float*)(ws + WS_VST);
#ifndef PHMASK
#define PHMASK 0x7fff
#endif
#define IN(k) (((PHMASK >> (k)) & 1) && lo <= (k) && (k) < hi)
#define SEAM(k) do { if (IN(k) && IN((k) + 1)) grid.sync(); } while (0)
    if (IN(0)) prep_phase(lds, P);
    SEAM(0);
    if (IN(1)) {
        kv_phase(lds, P);
        run_gemm(lds, HB, (const bf16_t*)((unsigned char*)W + OW_GU1), MTOK, 2 * DFF, DM, EpiSwiglu{S0, SS});
    }
    SEAM(1);
    if (IN(2)) run_gemm(lds, S0, (const bf16_t*)((unsigned char*)W + OW_DN1), MTOK, DM, DFF, EpiRes{P.in[0], P.out, HB, SS, 0.5f});
    SEAM(2);
    if (IN(3)) run_gemm(lds, HB, (const bf16_t*)((unsigned char*)W + OW_IN), MTOK, DIN, DM, EpiWin{SS, P.in[7], S0, S1, VST});
    SEAM(3);
    if (IN(4)) conv_phase(lds, P);
    SEAM(4);
    if (IN(5)) sgu_phase(lds, P);
    SEAM(5);
    if (IN(6)) run_gemm(lds, HB, (const bf16_t*)((unsigned char*)W + OW_A), MTOK, DM, DM, EpiGate<0>{S3, YA, nullptr, nullptr});
    SEAM(6);
    if (IN(7)) run_gemm(lds, S0, (const bf16_t*)((unsigned char*)W + OW_B), MTOK, DM, DM, EpiGate<1>{S4, YA, HB, nullptr});
    SEAM(7);
    if (IN(8)) run_gemm(lds, HB, (const bf16_t*)((unsigned char*)W + OW_OUT), MTOK, DM, DM, EpiRes{P.out, P.out, S0, SS, 1.0f});
    SEAM(8);
    if (IN(9)) run_gemm(lds, S0, (const bf16_t*)((unsigned char*)W + OW_Q), MTOK, DM, DM, EpiGate<2>{nullptr, nullptr, S3, SS});
    SEAM(9);
    if (IN(10)) attn_phase(lds, P);
    SEAM(10);
    if (IN(11)) run_gemm(lds, S4, (const bf16_t*)((unsigned char*)W + OW_O), MTOK, DM, DM, EpiRes{P.out, P.out, HB, SS, 1.0f});
    SEAM(11);
    if (IN(12)) run_gemm(lds, HB, (const bf16_t*)((unsigned char*)W + OW_GU2), MTOK, 2 * DFF, DM, EpiSwiglu{S0, SS});
    SEAM(12);
    if (IN(13)) run_gemm(lds, S0, (const bf16_t*)((unsigned char*)W + OW_DN2), MTOK, DM, DFF, EpiRes{P.out, P.out, nullptr, SS, 0.5f});
    SEAM(13);
    if (IN(14)) final_phase(P);
#undef IN
#undef SEAM
}
constexpr int NPHASE = 15;

#ifndef N_LAUNCH_PER_PHASE
#define N_LAUNCH_PER_PHASE 0
#endif

extern "C" void kernel_launch(void* const* d_in, const int* in_sizes, int n_in, void* d_out, int out_size, void* d_ws, size_t ws_size, hipStream_t stream) {
    static int grid_blocks = 0;
    if (!grid_blocks) {
        int dev = 0, cus = 0, per_cu = 0;
        hipGetDevice(&dev);
        hipDeviceGetAttribute(&cus, hipDeviceAttributeMultiprocessorCount, dev);
        hipFuncSetAttribute((const void*)mega_fwd, hipFuncAttributeMaxDynamicSharedMemorySize, LDS_BYTES);
        hipOccupancyMaxActiveBlocksPerMultiprocessor(&per_cu, (const void*)mega_fwd, NTHR, LDS_BYTES);
        if (per_cu < 1) { fprintf(stderr, "occupancy query says %d blocks/CU\n", per_cu); per_cu = 1; }
        grid_blocks = cus * per_cu;
        if (ws_size < WS_END || n_in != 28) fprintf(stderr, "unexpected ws_size %zu / n_in %d\n", ws_size, n_in);
    }
    Params p;
    memset(&p, 0, sizeof(p));
    for (int i = 0; i < 28; ++i) p.in[i] = (const float*)d_in[i];
    p.out = (float*)d_out; p.ws = (unsigned char*)d_ws;
    unsigned char* W = (unsigned char*)d_ws + WS_W;
    auto setw = [&](int i, int src, size_t off, int K, int Nsrc, int Nout, int mode, int ksc, float csc) {
        p.wd[i].src = (const float*)d_in[src]; p.wd[i].dst = (bf16_t*)(W + off); p.wd[i].ksc = ksc >= 0 ? (const float*)d_in[ksc] : nullptr;
        p.wd[i].K = K; p.wd[i].Nsrc = Nsrc; p.wd[i].Nout = Nout; p.wd[i].mode = mode; p.wd[i].csc = csc; p.wd[i].pad = 0; };
    setw(0, 3, OW_GU1, 1024, 5632, 5632, 1, 2, 1.0f);
    setw(1, 4, OW_DN1, 2816, 1024, 1024, 0, -1, 1.0f);
    setw(2, 6, OW_IN, 1024, 6144, 6144, 2, 5, 1.0f);
    setw(3, 12, OW_A, 1024, 1024, 1024, 0, -1, 1.0f);
    setw(4, 17, OW_B, 1024, 1024, 1024, 0, -1, 1.0f);
    setw(5, 18, OW_OUT, 1024, 1024, 1024, 0, -1, 1.0f);
    setw(6, 21, OW_Q, 1024, 1024, 1024, 0, 19, 0.0625f);
    setw(7, 23, OW_O, 1024, 1024, 1024, 0, -1, 1.0f);
    setw(8, 22, OW_KV, 1024, 2048, 2048, 0, -1, 1.0f);
    setw(9, 25, OW_GU2, 1024, 5632, 5632, 1, 24, 1.0f);
    setw(10, 26, OW_DN2, 2816, 1024, 1024, 0, -1, 1.0f);
#if N_LAUNCH_PER_PHASE
    for (int ph = 0; ph < NPHASE; ++ph) {
        p.ph_lo = ph; p.ph_hi = ph + 1;
        hipLaunchKernelGGL(mega_fwd, dim3(grid_blocks), dim3(NTHR), LDS_BYTES, stream, p);
    }
#else
    p.ph_lo = 0; p.ph_hi = NPHASE;
    void* args[] = {&p};
    hipError_t e = hipLaunchCooperativeKernel((const void*)mega_fwd, dim3(grid_blocks), dim3(NTHR), args, LDS_BYTES, stream);
    if (e != hipSuccess) fprintf(stderr, "cooperative launch failed: %s (grid %d)\n", hipGetErrorString(e), grid_blocks);
#endif
}
```

```cpp
#include <hip/hip_runtime.h>
#include <hip/hip_cooperative_groups.h>
#include <cstdio>
namespace cg = cooperative_groups;

#include <cstring>
#include <utility>
namespace pg8 {
#define PG8_LAS __attribute__((address_space(3)))
typedef unsigned short bf16_t;
typedef short bf16x8 __attribute__((ext_vector_type(8)));
typedef float f32x4 __attribute__((ext_vector_type(4)));
typedef unsigned u32x4 __attribute__((ext_vector_type(4)));
constexpr int BM = 256, BK = 64, HALF = 128, HTB = HALF * BK * 2  , STAGE_BYTES = 8 * HTB, NXCD = 8, WGM = 8;

__host__ __device__ __forceinline__ int lds_byte(int r, int c) { const int st = (r >> 4) * 2 + (c >> 5), rr = r & 15, cc = c & 31, ob = rr * 64 + cc * 2; return st * 1024 + (ob ^ (((ob >> 9) & 1) << 5)); }
__host__ __device__ __forceinline__ void stage_rc(int b, int& R, int& C) { const int st = b / 1024, sb = b % 1024, swz = sb ^ (((sb >> 9) & 1) << 5); R = (st >> 1) * 16 + swz / 64; C = (st & 1) * 32 + (swz % 64) / 2; }
__host__ __device__ __forceinline__ int perm32(int rho) { const int n = rho >> 4, i = rho & 15; return 8 * (i >> 2) + 4 * n + (i & 3); }

struct Unit { int pm, pn; };
struct Gemm { const bf16_t* A; const bf16_t* Bt; int M, N, K; };

struct StaticOrder {
    int nM, nN, nwg, G, c;
    __host__ __device__ void init(int M, int N, int G_, int c_) { nM = M / BM; nN = N / BM; nwg = nM * nN; G = G_; c = c_; }
    __host__ __device__ bool next(int i, Unit& u) const {
        const long L = (long)i * G + c; if (L >= nwg) return false;
        int wgid = (int)L; { const int q = nwg / NXCD, r = nwg % NXCD, xcd = wgid % NXCD, off = wgid / NXCD; wgid = (xcd < r ? xcd * (q + 1) : r * (q + 1) + (xcd - r) * q) + off; }
        const int nig = WGM * nN, gid = wgid / nig, fm = gid * WGM, gsz = (nM - fm) < WGM ? (nM - fm) : WGM;
        u.pm = fm + ((wgid % nig) % gsz); u.pn = (wgid % nig) / gsz; return true;
    }
    __device__ __forceinline__ void a_ready(const Unit&) const {}
    __device__ __forceinline__ void done(const Unit&) const {}
};

template <class Epi, class Sched, bool ALIGN_EPI = false, bool SP2 = false>
__device__ __forceinline__ void gemm_phase(PG8_LAS unsigned char* lds, const Gemm g, const Sched& S, const Epi& E) {
    const int tid = threadIdx.x, wid = __builtin_amdgcn_readfirstlane(tid >> 6), lane = tid & 63, wr = wid >> 2, wc = wid & 3, fr = lane & 15, fq = lane >> 4;
    const int K = g.K, nt = K / BK;
    unsigned voffA[2], voffB[2];
#pragma unroll
    for (int i = 0; i < 2; ++i) { int R, C; stage_rc(tid * 16 + i * 8192, R, C); const int Rb = Epi::PERM ? ((R & ~31) + perm32(R & 31)) : R;
        voffA[i] = (unsigned)(R * K + C) * 2u; voffB[i] = (unsigned)(Rb * K + C) * 2u; }
    const size_t kstep = (size_t)(BK * 2);
    const size_t hstep = (size_t)HALF * K * 2;
    const size_t tstep = 2 * hstep;
    const unsigned ldsw = (unsigned)wid * 1024u;
    const int aoff = lds_byte(wr * 64 + fr, fq * 8), boff = lds_byte(wc * 32 + fr, fq * 8);
#define PG8_SA(b, h) (((b) * 2 + (h)) * HTB)
#define PG8_SB(b, h) ((4 + (b) * 2 + (h)) * HTB)
#define PG8_STAGE(bufoff, gbase, voff) do { _Pragma("unroll") for (int _i = 0; _i < 2; ++_i) \
        __builtin_amdgcn_global_load_lds((const unsigned*)((const char*)(gbase) + (voff)[_i]), (PG8_LAS unsigned*)(lds + (bufoff) + ldsw + _i * 8192), 16, 0, 0); } while (0)
#define PG8_LDA(dst, b, h) do { _Pragma("unroll") for (int m = 0; m < 4; ++m) _Pragma("unroll") for (int k = 0; k < 2; ++k) dst[m][k] = *(const PG8_LAS bf16x8*)(lds + PG8_SA(b, h) + aoff + m * 2048 + k * 1024); } while (0)
#define PG8_LDB(dst, b, h) do { _Pragma("unroll") for (int n = 0; n < 2; ++n) _Pragma("unroll") for (int k = 0; k < 2; ++k) dst[n][k] = *(const PG8_LAS bf16x8*)(lds + PG8_SB(b, h) + boff + n * 2048 + k * 1024); } while (0)
#define PG8_MMA(ai, bj, At, Bt) do { __builtin_amdgcn_s_setprio(1); _Pragma("unroll") for (int m = 0; m < 4; ++m) _Pragma("unroll") for (int n = 0; n < 2; ++n) _Pragma("unroll") for (int k = 0; k < 2; ++k) \
        acc[ai][bj][m][n] = __builtin_amdgcn_mfma_f32_16x16x32_bf16(Bt[n][k], At[m][k], acc[ai][bj][m][n], 0, 0, 0); __builtin_amdgcn_s_setprio(0); } while (0)
#define PG8_WAIT_V(n) asm volatile("s_waitcnt vmcnt(" #n ")" ::: "memory")
#define PG8_WAIT_L(n) asm volatile("s_waitcnt lgkmcnt(" #n ")" ::: "memory")
#define PG8_BAR __builtin_amdgcn_s_barrier()
#define PG8_SCHED __builtin_amdgcn_sched_barrier(0)
    Unit cur, nxt; int ui = 0;
    if (!S.next(0, cur)) return;
    f32x4 acc[2][2][4][2];
#pragma unroll
    for (int a = 0; a < 2; ++a)
#pragma unroll
        for (int b = 0; b < 2; ++b)
#pragma unroll
            for (int m = 0; m < 4; ++m)
#pragma unroll
                for (int n = 0; n < 2; ++n) acc[a][b][m][n] = (f32x4){0.f, 0.f, 0.f, 0.f};
    bf16x8 At[4][2], B0[2][2], B1[2][2];
    const char* cA = (const char*)g.A + (size_t)cur.pm * tstep; const char* cB = (const char*)g.Bt + (size_t)cur.pn * tstep;
    S.a_ready(cur);
    if constexpr (SP2) {
        PG8_STAGE(PG8_SB(0, 0), cB, voffB); PG8_STAGE(PG8_SB(0, 1), cB + hstep, voffB); PG8_STAGE(PG8_SA(0, 0), cA, voffA); PG8_STAGE(PG8_SA(0, 1), cA + hstep, voffA);
        if (wr == 1) PG8_BAR;
        PG8_WAIT_V(2); PG8_BAR;
        PG8_STAGE(PG8_SB(1, 0), cB + kstep, voffB); PG8_STAGE(PG8_SA(1, 0), cA + kstep, voffA); PG8_STAGE(PG8_SB(1, 1), cB + hstep + kstep, voffB);
        PG8_WAIT_V(6); PG8_BAR;
    } else {
        PG8_STAGE(PG8_SB(0, 0), cB, voffB); PG8_STAGE(PG8_SA(0, 0), cA, voffA); PG8_STAGE(PG8_SB(0, 1), cB + hstep, voffB); PG8_STAGE(PG8_SA(0, 1), cA + hstep, voffA);
        if (wr == 1) PG8_BAR;
        PG8_WAIT_V(4); PG8_BAR;
        PG8_STAGE(PG8_SB(1, 0), cB + kstep, voffB); PG8_STAGE(PG8_SA(1, 0), cA + kstep, voffA); PG8_STAGE(PG8_SB(1, 1), cB + hstep + kstep, voffB);
        PG8_WAIT_V(6); PG8_BAR;
    }
    for (;;) {
        const bool has_next = S.next(ui + 1, nxt);
        const char* nA = has_next ? (const char*)g.A + (size_t)nxt.pm * tstep : cA; const char* nB = has_next ? (const char*)g.Bt + (size_t)nxt.pn * tstep : cB;
        for (int t = 0; t < nt; t += 2) {
            const bool last = (t == nt - 2);
            const char* a1 = cA + (size_t)(t + 1) * kstep;
            const char* a2 = last ? nA : cA + (size_t)(t + 2) * kstep; const char* b2 = last ? nB : cB + (size_t)(t + 2) * kstep;
            const char* a3 = a2 + kstep; const char* b3 = b2 + kstep;
            if (last && has_next) S.a_ready(nxt);
            if constexpr (Epi::MIDK) { if (t == (nt >> 1)) E.mid(acc, cur, wr, wc, fr, fq); }
            if constexpr (SP2) {
            PG8_LDB(B0, 0, 0); PG8_LDB(B1, 0, 1); PG8_SCHED; PG8_LDA(At, 0, 0); PG8_STAGE(PG8_SA(1, 1), a1 + hstep, voffA);
            PG8_WAIT_V(8); PG8_WAIT_L(0); PG8_BAR; PG8_MMA(0, 0, At, B0); PG8_MMA(0, 1, At, B1); PG8_BAR; PG8_SCHED;
            PG8_LDA(At, 0, 1); PG8_STAGE(PG8_SB(0, 0), b2, voffB); PG8_STAGE(PG8_SB(0, 1), b2 + hstep, voffB); PG8_STAGE(PG8_SA(0, 0), a2, voffA);
            PG8_WAIT_V(8); PG8_WAIT_L(0); PG8_BAR; PG8_MMA(1, 0, At, B0); PG8_MMA(1, 1, At, B1); PG8_BAR; PG8_SCHED;
            PG8_LDB(B0, 1, 0); PG8_LDB(B1, 1, 1); PG8_SCHED; PG8_LDA(At, 1, 0); PG8_STAGE(PG8_SA(0, 1), a2 + hstep, voffA);
            PG8_WAIT_V(8); PG8_WAIT_L(0); PG8_BAR; PG8_MMA(0, 0, At, B0); PG8_MMA(0, 1, At, B1); PG8_BAR; PG8_SCHED;
            PG8_LDA(At, 1, 1); PG8_STAGE(PG8_SB(1, 0), b3, voffB); PG8_STAGE(PG8_SB(1, 1), b3 + hstep, voffB); PG8_STAGE(PG8_SA(1, 0), a3, voffA);
            PG8_WAIT_V(8); PG8_WAIT_L(0); PG8_BAR; PG8_MMA(1, 0, At, B0); PG8_MMA(1, 1, At, B1); PG8_BAR; PG8_SCHED;
            } else {
            PG8_LDB(B0, 0, 0); PG8_SCHED; PG8_LDA(At, 0, 0); PG8_STAGE(PG8_SA(1, 1), a1 + hstep, voffA);
            PG8_WAIT_L(8); PG8_BAR; PG8_WAIT_L(0); PG8_MMA(0, 0, At, B0); PG8_BAR; PG8_SCHED;
            PG8_LDB(B1, 0, 1); PG8_STAGE(PG8_SB(0, 0), b2, voffB);
            PG8_BAR; PG8_WAIT_L(0); PG8_MMA(0, 1, At, B1); PG8_BAR;
            PG8_LDA(At, 0, 1); PG8_STAGE(PG8_SA(0, 0), a2, voffA);
            PG8_BAR; PG8_WAIT_L(0); PG8_MMA(1, 0, At, B0); PG8_BAR; PG8_SCHED;
            PG8_STAGE(PG8_SB(0, 1), b2 + hstep, voffB);
            PG8_WAIT_V(6); PG8_BAR; PG8_MMA(1, 1, At, B1); PG8_BAR;
            PG8_LDB(B0, 1, 0); PG8_SCHED; PG8_LDA(At, 1, 0); PG8_STAGE(PG8_SA(0, 1), a2 + hstep, voffA);
            PG8_WAIT_L(8); PG8_BAR; PG8_WAIT_L(0); PG8_MMA(0, 0, At, B0); PG8_BAR; PG8_SCHED;
            PG8_LDB(B1, 1, 1); PG8_STAGE(PG8_SB(1, 0), b3, voffB);
            PG8_BAR; PG8_WAIT_L(0); PG8_MMA(0, 1, At, B1); PG8_BAR;
            PG8_LDA(At, 1, 1); PG8_STAGE(PG8_SA(1, 0), a3, voffA);
            PG8_BAR; PG8_WAIT_L(0); PG8_MMA(1, 0, At, B0); PG8_BAR; PG8_SCHED;
            PG8_STAGE(PG8_SB(1, 1), b3 + hstep, voffB);
            PG8_WAIT_V(6); PG8_BAR; PG8_MMA(1, 1, At, B1); PG8_BAR;
            }
        }
        if constexpr (ALIGN_EPI) { if (wr == 0) PG8_BAR; }
        if constexpr (!Epi::AFTER_DRAIN) { E(acc, cur, wr, wc, fr, fq); S.done(cur); }
        if (!has_next) break;
#pragma unroll
        for (int a = 0; a < 2; ++a)
#pragma unroll
            for (int b = 0; b < 2; ++b)
#pragma unroll
                for (int m = 0; m < 4; ++m)
#pragma unroll
                    for (int n = 0; n < 2; ++n) acc[a][b][m][n] = (f32x4){0.f, 0.f, 0.f, 0.f};
        cur = nxt; cA = nA; cB = nB; ++ui;
        if constexpr (ALIGN_EPI) { if (wr == 1) PG8_BAR; }
    }
    PG8_WAIT_V(0);
    if constexpr (!ALIGN_EPI) { if (wr == 0) PG8_BAR; }
    PG8_BAR;
    if constexpr (Epi::AFTER_DRAIN) { E.fused(acc, cur, wr, wc, fr, fq, lds, wid, lane); S.done(cur); }
#undef PG8_SA
#undef PG8_SB
#undef PG8_STAGE
#undef PG8_LDA
#undef PG8_LDB
#undef PG8_MMA
#undef PG8_WAIT_V
#undef PG8_WAIT_L
#undef PG8_BAR
#undef PG8_SCHED
}
}

using pg8::bf16_t; using pg8::bf16x8; using pg8::f32x4; using pg8::u32x4; using pg8::Unit;
#define LAS __attribute__((address_space(3)))
typedef unsigned u32x2 __attribute__((ext_vector_type(2)));
typedef float f32x2 __attribute__((ext_vector_type(2)));

constexpr int MTOK = 32768, DM = 1024, DFF = 2816, SEQ = 16384, NMEM = 256, DIN = 6144;
constexpr int NTHR = 512;
constexpr size_t MiB = 1024 * 1024;
constexpr size_t WS_W = 0;
constexpr size_t OW_GU1 = 0, OW_DN1 = OW_GU1 + (size_t)5632 * 1024 * 2, OW_IN = OW_DN1 + (size_t)1024 * 2816 * 2, OW_A = OW_IN + (size_t)6144 * 1024 * 2,
                 OW_B = OW_A + 2 * MiB, OW_OUT = OW_B + 2 * MiB, OW_Q = OW_OUT + 2 * MiB, OW_O = OW_Q + 2 * MiB, OW_KV = OW_O + 2 * MiB,
                 OW_GU2 = OW_KV + 4 * MiB, OW_DN2 = OW_GU2 + (size_t)5632 * 1024 * 2, OW_END = OW_DN2 + (size_t)1024 * 2816 * 2;
static_assert(OW_END <= 64 * MiB, "weights region");
constexpr size_t WS_HB = 64 * MiB;
constexpr size_t WS_R1 = 128 * MiB;
constexpr size_t SLOT = 64 * MiB;
constexpr size_t WS_SS = 448 * MiB;
constexpr size_t WS_VST = 450 * MiB;
constexpr size_t WS_KB = 454 * MiB;
constexpr size_t WS_VT = 455 * MiB;
constexpr size_t WS_MEMN = 456 * MiB;
constexpr size_t WS_END = 457 * MiB;
constexpr int LDS_BYTES = 256 * 528;

struct WDesc { const float* src; bf16_t* dst; const float* ksc; int K, Nsrc, Nout, mode; float csc; int ldd; };
struct Params {
    const float* in[28]; float* out; unsigned char* ws;
    WDesc wd[11];
    int ph_lo, ph_hi;
};

__device__ __forceinline__ unsigned pk2(float lo, float hi) { unsigned r; asm volatile("v_cvt_pk_bf16_f32 %0, %1, %2" : "=v"(r) : "v"(lo), "v"(hi)); return r; }
__device__ __forceinline__ float bflo(unsigned w) { return __uint_as_float(w << 16); }
__device__ __forceinline__ float bfhi(unsigned w) { return __uint_as_float(w & 0xffff0000u); }
__device__ __forceinline__ float fsigmoid(float x) { return __builtin_amdgcn_rcpf(1.0f + __expf(-x)); }
__device__ __forceinline__ float fsilu(float x) { return x * fsigmoid(x); }
__device__ __forceinline__ float fgelu(float x) { return x * fsigmoid(1.5957691216057308f * (x + 0.044715f * x * x * x)); }
__device__ __forceinline__ float row_rs(const float* ss, int row) {
    const f32x4* p = (const f32x4*)(ss + (size_t)row * 16);
    const f32x4 a = p[0], b = p[1], c = p[2], d = p[3];
    const float s = ((a[0] + a[1]) + (a[2] + a[3])) + ((b[0] + b[1]) + (b[2] + b[3])) + ((c[0] + c[1]) + (c[2] + c[3])) + ((d[0] + d[1]) + (d[2] + d[3]));
    return rsqrtf(s * (1.0f / 1024.0f) + 1e-6f);
}
__device__ __forceinline__ float xor16_32_sum(float v) { v += __shfl_xor(v, 16); v += __shfl_xor(v, 32); return v; }

struct EpiSwiglu {
    static constexpr bool PERM = true, AFTER_DRAIN = false, MIDK = false;
    bf16_t* out; const float* ss;
    __device__ __forceinline__ void operator()(const f32x4 (&acc)[2][2][4][2], const Unit& u, int wr, int wc, int fr, int fq) const {
        const int row0 = u.pm * 256 + wr * 64 + fr, col0 = u.pn * 128 + wc * 32 + 8 * fq;
#pragma unroll
        for (int ai = 0; ai < 2; ++ai)
#pragma unroll
            for (int m = 0; m < 4; ++m) {
                const int row = row0 + ai * 128 + m * 16; const float r = row_rs(ss, row);
                u32x4 w;
#pragma unroll
                for (int n = 0; n < 2; ++n)
#pragma unroll
                    for (int jj = 0; jj < 2; ++jj) {
                        const float g0 = r * acc[ai][0][m][n][2 * jj], g1 = r * acc[ai][0][m][n][2 * jj + 1];
                        const float u0 = r * acc[ai][1][m][n][2 * jj], u1 = r * acc[ai][1][m][n][2 * jj + 1];
                        w[n * 2 + jj] = pk2(fsilu(g0) * u0, fsilu(g1) * u1);
                    }
                *(u32x4*)(out + (size_t)row * DFF + col0) = w;
            }
    }
};
struct EpiRes {
    static constexpr bool PERM = true, AFTER_DRAIN = false, MIDK = false;
    bf16_t* h; float* ss; float scale;
    __device__ __forceinline__ void operator()(const f32x4 (&acc)[2][2][4][2], const Unit& u, int wr, int wc, int fr, int fq) const {
        const int row0 = u.pm * 256 + wr * 64 + fr, col0 = u.pn * 256 + wc * 32 + 8 * fq;
#pragma unroll
        for (int ai = 0; ai < 2; ++ai)
#pragma unroll
            for (int m = 0; m < 4; ++m) {
                const int row = row0 + ai * 128 + m * 16; float sq = 0.f;
#pragma unroll
                for (int bj = 0; bj < 2; ++bj) {
                    const size_t o = (size_t)row * DM + col0 + bj * 128;
                    const u32x4 x = *(const u32x4*)(h + o);
                    f32x4 x0, x1; x0[0] = bflo(x[0]); x0[1] = bfhi(x[0]); x0[2] = bflo(x[1]); x0[3] = bfhi(x[1]); x1[0] = bflo(x[2]); x1[1] = bfhi(x[2]); x1[2] = bflo(x[3]); x1[3] = bfhi(x[3]);
                    const f32x4 v0 = x0 + scale * acc[ai][bj][m][0], v1 = x1 + scale * acc[ai][bj][m][1];
                    sq += (v0[0] * v0[0] + v0[1] * v0[1]) + (v0[2] * v0[2] + v0[3] * v0[3]) + (v1[0] * v1[0] + v1[1] * v1[1]) + (v1[2] * v1[2] + v1[3] * v1[3]);
                    u32x4 w; w[0] = pk2(v0[0], v0[1]); w[1] = pk2(v0[2], v0[3]); w[2] = pk2(v1[0], v1[1]); w[3] = pk2(v1[2], v1[3]); *(u32x4*)(h + o) = w;
                }
                sq = xor16_32_sum(sq);
                if (fq == 0) ss[(size_t)row * 16 + u.pn * 4 + wc] = sq;
            }
    }
};
struct EpiWin {
    static constexpr bool PERM = true, AFTER_DRAIN = false, MIDK = false;
    const float* ss; const float* bias; bf16_t* a_out; bf16_t* g_out; float* vst; bf16_t* xr;
    __device__ __forceinline__ void operator()(const f32x4 (&acc)[2][2][4][2], const Unit& u, int wr, int wc, int fr, int fq) const {
        const int row0 = u.pm * 256 + wr * 64 + fr; const int pn = u.pn;
        if (pn < 8) {
            const int col0 = pn * 128 + wc * 32 + 8 * fq;
            const f32x4 bv0 = *(const f32x4*)(bias + col0), bv1 = *(const f32x4*)(bias + col0 + 4), bg0 = *(const f32x4*)(bias + 1024 + col0), bg1 = *(const f32x4*)(bias + 1024 + col0 + 4);
#pragma unroll
            for (int ai = 0; ai < 2; ++ai)
#pragma unroll
                for (int m = 0; m < 4; ++m) {
                    const int row = row0 + ai * 128 + m * 16; const float r = row_rs(ss, row);
                    const f32x4 v0 = r * acc[ai][0][m][0] + bv0, v1 = r * acc[ai][0][m][1] + bv1, g0 = r * acc[ai][1][m][0] + bg0, g1 = r * acc[ai][1][m][1] + bg1;
                    u32x4 w;
                    w[0] = pk2(v0[0] * fsigmoid(g0[0]), v0[1] * fsigmoid(g0[1])); w[1] = pk2(v0[2] * fsigmoid(g0[2]), v0[3] * fsigmoid(g0[3]));
                    w[2] = pk2(v1[0] * fsigmoid(g1[0]), v1[1] * fsigmoid(g1[1])); w[3] = pk2(v1[2] * fsigmoid(g1[2]), v1[3] * fsigmoid(g1[3]));
                    *(u32x4*)(a_out + (size_t)row * DM + col0) = w;
                }
        } else {
            const int idx = (pn - 8) >> 2; const int cb = ((pn - 8) & 3) * 256 + wc * 32 + 8 * fq;
            bf16_t* ob = idx == 0 ? xr : g_out + (size_t)idx * MTOK * DM; const int ldo = idx == 0 ? 2 * DM : DM;
            f32x4 b[2][2];
#pragma unroll
            for (int bj = 0; bj < 2; ++bj) { b[bj][0] = *(const f32x4*)(bias + 2048 + idx * 1024 + cb + bj * 128); b[bj][1] = *(const f32x4*)(bias + 2048 + idx * 1024 + cb + bj * 128 + 4); }
#pragma unroll
            for (int ai = 0; ai < 2; ++ai)
#pragma unroll
                for (int m = 0; m < 4; ++m) {
                    const int row = row0 + ai * 128 + m * 16; const float r = row_rs(ss, row);
                    float s1 = 0.f, s2 = 0.f;
#pragma unroll
                    for (int bj = 0; bj < 2; ++bj) {
                        f32x4 v0 = r * acc[ai][bj][m][0] + b[bj][0], v1 = r * acc[ai][bj][m][1] + b[bj][1];
                        if (idx < 2) {
#pragma unroll
                            for (int j = 0; j < 4; ++j) { v0[j] = fgelu(v0[j]); v1[j] = fgelu(v1[j]); }
                        } else {
#pragma unroll
                            for (int j = 0; j < 4; ++j) { v0[j] = fsigmoid(v0[j]); v1[j] = fsigmoid(v1[j]); }
                        }
                        s1 += (v0[0] + v0[1]) + (v0[2] + v0[3]) + (v1[0] + v1[1]) + (v1[2] + v1[3]);
                        s2 += (v0[0] * v0[0] + v0[1] * v0[1]) + (v0[2] * v0[2] + v0[3] * v0[3]) + (v1[0] * v1[0] + v1[1] * v1[1]) + (v1[2] * v1[2] + v1[3] * v1[3]);
                        u32x4 w; w[0] = pk2(v0[0], v0[1]); w[1] = pk2(v0[2], v0[3]); w[2] = pk2(v1[0], v1[1]); w[3] = pk2(v1[2], v1[3]);
                        *(u32x4*)(ob + (size_t)row * ldo + cb + bj * 128) = w;
                    }
                    if (idx == 1) {
                        s1 = xor16_32_sum(s1); s2 = xor16_32_sum(s2);
                        if (fq == 0) { f32x2 st; st[0] = s1; st[1] = s2; *(f32x2*)(vst + ((size_t)row * 16 + (pn - 12) * 4 + wc) * 2) = st; }
                    }
                }
        }
    }
};
struct EpiDual {
    static constexpr bool PERM = true, AFTER_DRAIN = false, MIDK = true;
    const bf16_t* sga; const bf16_t* sgb; bf16_t* ob;
    __device__ __forceinline__ void mid(f32x4 (&acc)[2][2][4][2], const Unit& u, int wr, int wc, int fr, int fq) const {
        int row0 = u.pm * 256 + wr * 64 + fr; const int col0 = u.pn * 256 + wc * 32 + 8 * fq;
        asm volatile("" : "+v"(row0));
#pragma unroll
        for (int ai = 0; ai < 2; ++ai)
#pragma unroll
            for (int m = 0; m < 4; ++m)
#pragma unroll
                for (int bj = 0; bj < 2; ++bj) {
                    const size_t o = (size_t)(row0 + ai * 128 + m * 16) * DM + col0 + bj * 128;
                    const u32x4 ga = *(const u32x4*)(sga + o), gb = *(const u32x4*)(sgb + o);
#pragma unroll
                    for (int e = 0; e < 4; ++e) {
                        const float r0 = bflo(ga[e]) * __builtin_amdgcn_rcpf(bflo(gb[e])), r1 = bfhi(ga[e]) * __builtin_amdgcn_rcpf(bfhi(gb[e]));
                        acc[ai][bj][m][e >> 1][(e & 1) * 2] *= r0; acc[ai][bj][m][e >> 1][(e & 1) * 2 + 1] *= r1;
                    }
                    if (bj == 1 && (m & 1)) __builtin_amdgcn_sched_barrier(0);
                }
    }
    __device__ __forceinline__ void operator()(const f32x4 (&acc)[2][2][4][2], const Unit& u, int wr, int wc, int fr, int fq) const {
        const int row0 = u.pm * 256 + wr * 64 + fr, col0 = u.pn * 256 + wc * 32 + 8 * fq;
#pragma unroll
        for (int ai = 0; ai < 2; ++ai)
#pragma unroll
            for (int m = 0; m < 4; ++m)
#pragma unroll
                for (int bj = 0; bj < 2; ++bj) {
                    const size_t o = (size_t)(row0 + ai * 128 + m * 16) * DM + col0 + bj * 128;
                    const u32x4 gb = *(const u32x4*)(sgb + o);
                    const f32x4 a0 = acc[ai][bj][m][0], a1 = acc[ai][bj][m][1];
                    u32x4 w; w[0] = pk2(a0[0] * bflo(gb[0]), a0[1] * bfhi(gb[0])); w[1] = pk2(a0[2] * bflo(gb[1]), a0[3] * bfhi(gb[1]));
                    w[2] = pk2(a1[0] * bflo(gb[2]), a1[1] * bfhi(gb[2])); w[3] = pk2(a1[2] * bflo(gb[3]), a1[3] * bfhi(gb[3]));
                    *(u32x4*)(ob + o) = w;
                }
    }
};
template <int MODE> struct EpiGate {
    static constexpr bool PERM = true, AFTER_DRAIN = false, MIDK = false;
    const bf16_t* sg; float* ya; bf16_t* ob; const float* ss;
    __device__ __forceinline__ void operator()(const f32x4 (&acc)[2][2][4][2], const Unit& u, int wr, int wc, int fr, int fq) const {
        const int row0 = u.pm * 256 + wr * 64 + fr, col0 = u.pn * 256 + wc * 32 + 8 * fq;
#pragma unroll
        for (int ai = 0; ai < 2; ++ai)
#pragma unroll
            for (int m = 0; m < 4; ++m) {
                const int row = row0 + ai * 128 + m * 16;
                float r = 1.f; if (MODE == 2) r = row_rs(ss, row);
#pragma unroll
                for (int bj = 0; bj < 2; ++bj) {
                    const size_t o = (size_t)row * DM + col0 + bj * 128;
                    f32x4 v0, v1;
                    if (MODE == 2) { v0 = r * acc[ai][bj][m][0]; v1 = r * acc[ai][bj][m][1]; }
                    else {
                        const u32x4 g = *(const u32x4*)(sg + o);
                        f32x4 s0, s1; s0[0] = bflo(g[0]); s0[1] = bfhi(g[0]); s0[2] = bflo(g[1]); s0[3] = bfhi(g[1]); s1[0] = bflo(g[2]); s1[1] = bfhi(g[2]); s1[2] = bflo(g[3]); s1[3] = bfhi(g[3]);
                        v0 = s0 * acc[ai][bj][m][0]; v1 = s1 * acc[ai][bj][m][1];
                        if (MODE == 1) { v0 += *(const f32x4*)(ya + o); v1 += *(const f32x4*)(ya + o + 4); }
                    }
                    if (MODE == 0) { *(f32x4*)(ya + o) = v0; *(f32x4*)(ya + o + 4) = v1; }
                    else { u32x4 w; w[0] = pk2(v0[0], v0[1]); w[1] = pk2(v0[2], v0[3]); w[2] = pk2(v1[0], v1[1]); w[3] = pk2(v1[2], v1[3]); *(u32x4*)(ob + o) = w; }
                }
            }
    }
};
__device__ __forceinline__ int vpos(int m) { return (m & ~31) | (((m >> 2) & 3) << 3) | (((m >> 4) & 1) << 2) | (m & 3); }
__device__ __forceinline__ int wmap(int mode, int n) {
    if (mode == 1) { const int p = n >> 8, bj = (n >> 7) & 1, c = n & 127; return bj * DFF + p * 128 + c; }
    if (mode == 2) { const int p = n >> 8; if (p < 8) { const int bj = (n >> 7) & 1, c = n & 127; return bj * 1024 + p * 128 + c; } return n; }
    return n;
}
__device__ void prep_phase(unsigned char* lds_g, const Params& P) {
    float* tile = (float*)lds_g;
    const int tid = threadIdx.x, G = gridDim.x;
    for (int d = 0; d < 11; ++d) {
        const WDesc w = P.wd[d];
        const int nkt = w.K / 64, ntl = nkt * (w.Nout / 64);
        for (int t = blockIdx.x; t < ntl; t += G) {
            const int kt = t % nkt, nb = t / nkt, k0 = kt * 64, n0 = nb * 64;
            const int sc0 = wmap(w.mode, n0);
            const int tk = tid >> 4, tn = (tid & 15) * 4;
#pragma unroll
            for (int i = 0; i < 2; ++i) {
                const int k = k0 + tk + 32 * i;
                f32x4 v = *(const f32x4*)(w.src + (size_t)k * w.Nsrc + sc0 + tn);
                const float sc = w.csc * (w.ksc ? w.ksc[k] : 1.0f);
                float* tp = tile + (tk + 32 * i) * 65 + tn;
                tp[0] = v[0] * sc; tp[1] = v[1] * sc; tp[2] = v[2] * sc; tp[3] = v[3] * sc;
            }
            __syncthreads();
            const int n = tid >> 3, kq = (tid & 7) * 8;
            u32x4 o;
#pragma unroll
            for (int e = 0; e < 4; ++e) o[e] = pk2(tile[(kq + 2 * e) * 65 + n], tile[(kq + 2 * e + 1) * 65 + n]);
            *(u32x4*)(w.dst + (size_t)(n0 + n) * w.ldd + k0 + kq) = o;
            __syncthreads();
        }
    }
    const int lane = tid & 63, gw = blockIdx.x * 8 + (tid >> 6), nw = G * 8;
    const float* x = P.in[0]; bf16_t* xb = (bf16_t*)(P.ws + WS_HB); float* ss = (float*)(P.ws + WS_SS);
    for (int row = gw; row < MTOK; row += nw) {
        float sq = 0.f;
#pragma unroll
        for (int i = 0; i < 4; ++i) {
            const f32x4 v = *(const f32x4*)(x + (size_t)row * DM + i * 256 + lane * 4);
            sq += (v[0] * v[0] + v[1] * v[1]) + (v[2] * v[2] + v[3] * v[3]);
            u32x2 o; o[0] = pk2(v[0], v[1]); o[1] = pk2(v[2], v[3]);
            *(u32x2*)(xb + (size_t)row * DM + i * 256 + lane * 4) = o;
        }
#pragma unroll
        for (int s = 1; s < 64; s <<= 1) sq += __shfl_xor(sq, s);
        if (lane < 16) ss[(size_t)row * 16 + lane] = lane == 0 ? sq : 0.f;
    }
    const float* mem = P.in[1]; const float* mg = P.in[20]; bf16_t* memn = (bf16_t*)(P.ws + WS_MEMN);
    for (int row = gw; row < 2 * NMEM; row += nw) {
        f32x4 v[4]; float sq = 0.f;
#pragma unroll
        for (int i = 0; i < 4; ++i) { v[i] = *(const f32x4*)(mem + (size_t)row * DM + i * 256 + lane * 4); sq += (v[i][0] * v[i][0] + v[i][1] * v[i][1]) + (v[i][2] * v[i][2] + v[i][3] * v[i][3]); }
#pragma unroll
        for (int s = 1; s < 64; s <<= 1) sq += __shfl_xor(sq, s);
        const float r = rsqrtf(sq * (1.0f / 1024.0f) + 1e-6f);
#pragma unroll
        for (int i = 0; i < 4; ++i) {
            const f32x4 g = *(const f32x4*)(mg + i * 256 + lane * 4);
            u32x2 o; o[0] = pk2(v[i][0] * r * g[0], v[i][1] * r * g[1]); o[1] = pk2(v[i][2] * r * g[2], v[i][3] * r * g[3]);
            *(u32x2*)(memn + (size_t)row * DM + i * 256 + lane * 4) = o;
        }
    }
}


__device__ void kv_phase(unsigned char* lds_g, const Params& P) {
    LAS float* red = (LAS float*)lds_g;
    const int tid = threadIdx.x, lane = tid & 63, wave = tid >> 6, fr = lane & 15, fq = lane >> 4;
    const bf16_t* memn = (const bf16_t*)(P.ws + WS_MEMN); const bf16_t* Wt = (const bf16_t*)(P.ws + WS_W + OW_KV);
    bf16_t* Kb = (bf16_t*)(P.ws + WS_KB); bf16_t* Vt = (bf16_t*)(P.ws + WS_VT);
    for (int tile = blockIdx.x; tile < 256; tile += gridDim.x) {
        const int tm = tile >> 5, tn = tile & 31;
        f32x4 acc[4][4];
#pragma unroll
        for (int i = 0; i < 4; ++i)
#pragma unroll
            for (int j = 0; j < 4; ++j) acc[i][j] = (f32x4){0.f, 0.f, 0.f, 0.f};
#pragma unroll
        for (int ks = 0; ks < 4; ++ks) {
            const int k = wave * 128 + ks * 32 + fq * 8;
            bf16x8 af[4], bf[4];
#pragma unroll
            for (int i = 0; i < 4; ++i) { af[i] = *(const bf16x8*)(memn + (size_t)(64 * tm + 16 * i + fr) * DM + k); bf[i] = *(const bf16x8*)(Wt + (size_t)(64 * tn + 16 * i + fr) * DM + k); }
#pragma unroll
            for (int mb = 0; mb < 4; ++mb)
#pragma unroll
                for (int nb = 0; nb < 4; ++nb) acc[mb][nb] = __builtin_amdgcn_mfma_f32_16x16x32_bf16(bf[nb], af[mb], acc[mb][nb], 0, 0, 0);
        }
        __syncthreads();
#pragma unroll
        for (int mb = 0; mb < 4; ++mb)
#pragma unroll
            for (int nb = 0; nb < 4; ++nb) *(LAS f32x4*)(red + (wave * 64 + 16 * mb + fr) * 64 + 16 * nb + 4 * fq) = acc[mb][nb];
        __syncthreads();
        const int b = tm >> 2, mbase = (tm & 3) * 64, col = (tn & 15) * 64, h = col >> 8, d0 = col & 255;
        float v[8];
#pragma unroll
        for (int j = 0; j < 8; ++j) v[j] = 0.f;
        if (tn < 16) {
            const int m = tid >> 3, n8 = (tid & 7) * 8;
#pragma unroll
            for (int w = 0; w < 8; ++w) { const f32x4 x0 = *(const LAS f32x4*)(red + (w * 64 + m) * 64 + n8), x1 = *(const LAS f32x4*)(red + (w * 64 + m) * 64 + n8 + 4);
#pragma unroll
                for (int j = 0; j < 4; ++j) { v[j] += x0[j]; v[4 + j] += x1[j]; } }
            u32x4 o; o[0] = pk2(v[0], v[1]); o[1] = pk2(v[2], v[3]); o[2] = pk2(v[4], v[5]); o[3] = pk2(v[6], v[7]);
            *(u32x4*)(Kb + ((size_t)(b * 4 + h) * 256 + mbase + m) * 256 + d0 + n8) = o;
        } else {
            const int n = tid >> 3, p8 = (tid & 7) * 8;
#pragma unroll
            for (int e = 0; e < 8; ++e) {
                const int pp = p8 + e, key = (pp & 32) | (((pp >> 2) & 1) << 4) | (((pp >> 3) & 3) << 2) | (pp & 3);
#pragma unroll
                for (int w = 0; w < 8; ++w) v[e] += red[(w * 64 + key) * 64 + n];
            }
            u32x4 o; o[0] = pk2(v[0], v[1]); o[1] = pk2(v[2], v[3]); o[2] = pk2(v[4], v[5]); o[3] = pk2(v[6], v[7]);
            *(u32x4*)(Vt + ((size_t)(b * 4 + h) * 256 + d0 + n) * 256 + mbase + p8) = o;
        }
    }
    __syncthreads();
}

__device__ void final_phase(const Params& P) {
    const int tid = threadIdx.x, lane = tid & 63, gw = blockIdx.x * 8 + (tid >> 6), nw = gridDim.x * 8;
    const bf16_t* h = (const bf16_t*)(P.ws + WS_HB); float* out = P.out; const float* ss = (const float*)(P.ws + WS_SS); const float* g = P.in[27];
    f32x4 gg[4];
#pragma unroll
    for (int i = 0; i < 4; ++i) gg[i] = *(const f32x4*)(g + i * 256 + lane * 4);
    for (int row = gw; row < MTOK; row += nw) {
        const float r = row_rs(ss, row);
#pragma unroll
        for (int i = 0; i < 4; ++i) {
            const u32x2 x = *(const u32x2*)(h + (size_t)row * DM + i * 256 + lane * 4);
            f32x4 v; v[0] = bflo(x[0]); v[1] = bfhi(x[0]); v[2] = bflo(x[1]); v[3] = bfhi(x[1]);
            *(f32x4*)(out + (size_t)row * DM + i * 256 + lane * 4) = v * r * gg[i];
        }
    }
}

template <int N> __device__ __forceinline__ void bfly(float (&v)[64], int lane) {
    const bool hi = (lane & N) != 0;
#pragma unroll
    for (int k = 0; k < N; ++k) { const float send = hi ? v[k] : v[k + N]; const float keep = hi ? v[k + N] : v[k]; v[k] = keep + __shfl_xor(send, N); }
}
constexpr int CT = 32, CROWS = CT + 30;
template <int S> __device__ __forceinline__ void conv_row(f32x2 (&acc)[CT], const f32x2 (&w)[31], const LAS unsigned char* lp) {
    const unsigned wv = *(const LAS unsigned*)(lp + S * 2048);
    f32x2 av; av[0] = bflo(wv); av[1] = bfhi(wv);
#pragma unroll
    for (int t = 0; t < CT; ++t) { if (S - t >= 0 && S - t <= 30) acc[t] += w[(S - t >= 0 && S - t <= 30) ? S - t : 0] * av; }
}
template <int... S> __device__ __forceinline__ void conv_all(f32x2 (&acc)[CT], const f32x2 (&w)[31], const LAS unsigned char* lp, std::integer_sequence<int, S...>) { (conv_row<S>(acc, w, lp), ...); }
__device__ void conv_phase(unsigned char* lds_g, const Params& P) {
    LAS unsigned char* lds = (LAS unsigned char*)lds_g;
    LAS float* red = (LAS float*)(lds + CROWS * 2048); LAS float* stat = red + 512;
    const int tid = threadIdx.x, lane = tid & 63, wave = tid >> 6, G = gridDim.x;
    const bf16_t* a = (const bf16_t*)(P.ws + WS_R1); bf16_t* ac = (bf16_t*)P.out;
    const float* cw = P.in[8];
    f32x2 w[31];
#pragma unroll
    for (int j = 0; j < 31; ++j) w[j] = *(const f32x2*)(cw + j * 1024 + 2 * tid);
    const f32x2 cb = *(const f32x2*)(P.in[9] + 2 * tid), lg = *(const f32x2*)(P.in[10] + 2 * tid), lb = *(const f32x2*)(P.in[11] + 2 * tid);
    for (int tile = blockIdx.x; tile < MTOK / CT; tile += G) {
        const int t0 = tile * CT, tin = t0 & (SEQ - 1);
#pragma unroll
        for (int i = 0; i < 16; ++i) {
            const int c = tid + NTHR * i, r = c >> 7, cc = c & 127;
            u32x4 v = {0u, 0u, 0u, 0u};
            if (r < CROWS && tin - 30 + r >= 0) v = *(const u32x4*)(a + (size_t)(t0 - 30 + r) * DM + cc * 8);
            if (r < CROWS) *(LAS u32x4*)(lds + r * 2048 + cc * 16) = v;
        }
        __syncthreads();
        f32x2 acc[CT];
#pragma unroll
        for (int t = 0; t < CT; ++t) acc[t] = cb;
        conv_all(acc, w, lds + tid * 4, std::make_integer_sequence<int, CROWS>{});
        float v[64];
#pragma unroll
        for (int t = 0; t < CT; ++t) { v[t] = acc[t][0] + acc[t][1]; v[32 + t] = acc[t][0] * acc[t][0] + acc[t][1] * acc[t][1]; }
        bfly<32>(v, lane); bfly<16>(v, lane); bfly<8>(v, lane); bfly<4>(v, lane); bfly<2>(v, lane); bfly<1>(v, lane);
        red[wave * 64 + lane] = v[0];
        __syncthreads();
        if (tid < 64) { float s = 0.f;
#pragma unroll
            for (int q = 0; q < 8; ++q) s += red[q * 64 + tid];
            stat[tid] = s; }
        __syncthreads();
#pragma unroll
        for (int t = 0; t < CT; ++t) {
            const float mean = stat[t] * (1.0f / 1024.0f), var = stat[32 + t] * (1.0f / 1024.0f) - mean * mean, rstd = rsqrtf(var + 1e-5f);
            const float y0 = (acc[t][0] - mean) * rstd * lg[0] + lb[0], y1 = (acc[t][1] - mean) * rstd * lg[1] + lb[1];
            *(unsigned*)(ac + (size_t)(t0 + t) * (2 * DM) + 2 * tid) = pk2(fsilu(y0), fsilu(y1));
        }
    }
    __syncthreads();
}

__device__ void sgu_phase(unsigned char* lds_g, const Params& P) {
    LAS unsigned char* lds = (LAS unsigned char*)lds_g;
    LAS unsigned char* Wl = lds;
    LAS unsigned char* Vl = lds + 128 * 272;
    LAS float* stat = (LAS float*)(lds + 128 * 272 + 128 * 520);
    const int tid = threadIdx.x, lane = tid & 63, wave = tid >> 6, fr = lane & 15, fq = lane >> 4, G = gridDim.x;
    const bf16_t* gv = (const bf16_t*)(P.ws + WS_R1 + 2 * SLOT);
    bf16_t* xr = (bf16_t*)P.out + DM;
    const float* vst = (const float*)(P.ws + WS_VST);
    const float* lng = P.in[13]; const float* lnb = P.in[14]; const float* sw = P.in[15]; const float* sbias = P.in[16];
    int lastg = -1;
    for (int u = blockIdx.x; u < 1024; u += G) {
        const int c = u >> 2, g = u & 3;
        __syncthreads();
        if (g != lastg) {
            lastg = g;
#pragma unroll
            for (int i = 0; i < 4; ++i) {
                const int e = tid + NTHR * i, t = e >> 4, s8 = (e & 15) * 8;
                const float* sp = sw + ((size_t)g * 128 + t) * 128 + s8;
                const f32x4 x0 = *(const f32x4*)sp, x1 = *(const f32x4*)(sp + 4);
                float f[8] = {x0[0], x0[1], x0[2], x0[3], x1[0], x1[1], x1[2], x1[3]};
#pragma unroll
                for (int j = 0; j < 8; ++j) if (s8 + j > t) f[j] = 0.f;
                u32x4 o; o[0] = pk2(f[0], f[1]); o[1] = pk2(f[2], f[3]); o[2] = pk2(f[4], f[5]); o[3] = pk2(f[6], f[7]);
                *(LAS u32x4*)(Wl + t * 272 + s8 * 2) = o;
            }
        }
        if (tid < 128) {
            const f32x4* p = (const f32x4*)(vst + (size_t)(c * 128 + tid) * 32);
            float s1 = 0.f, s2 = 0.f;
#pragma unroll
            for (int q = 0; q < 8; ++q) { const f32x4 x = p[q]; s1 += x[0] + x[2]; s2 += x[1] + x[3]; }
            const float mean = s1 * (1.0f / 1024.0f), var = s2 * (1.0f / 1024.0f) - mean * mean;
            stat[tid * 2] = mean; stat[tid * 2 + 1] = rsqrtf(var + 1e-5f);
        }
        __syncthreads();
#pragma unroll
        for (int i = 0; i < 8; ++i) {
            const int e = tid + NTHR * i, s = e >> 5, c8 = (e & 31) * 8;
            const u32x4 raw = *(const u32x4*)(gv + (size_t)(c * 128 + s) * DM + g * 256 + c8);
            const float mean = stat[s * 2], rstd = stat[s * 2 + 1];
            const f32x4 g0 = *(const f32x4*)(lng + g * 256 + c8), g1 = *(const f32x4*)(lng + g * 256 + c8 + 4), b0 = *(const f32x4*)(lnb + g * 256 + c8), b1 = *(const f32x4*)(lnb + g * 256 + c8 + 4);
            float f[8] = {bflo(raw[0]), bfhi(raw[0]), bflo(raw[1]), bfhi(raw[1]), bflo(raw[2]), bfhi(raw[2]), bflo(raw[3]), bfhi(raw[3])};
#pragma unroll
            for (int j = 0; j < 4; ++j) { f[j] = (f[j] - mean) * rstd * g0[j] + b0[j]; f[4 + j] = (f[4 + j] - mean) * rstd * g1[j] + b1[j]; }
            u32x2 o0, o1; o0[0] = pk2(f[0], f[1]); o0[1] = pk2(f[2], f[3]); o1[0] = pk2(f[4], f[5]); o1[1] = pk2(f[6], f[7]);
            *(LAS u32x2*)(Vl + s * 520 + c8 * 2) = o0; *(LAS u32x2*)(Vl + s * 520 + c8 * 2 + 8) = o1;
        }
        __syncthreads();
        f32x4 acc[2][8];
#pragma unroll
        for (int db = 0; db < 2; ++db)
#pragma unroll
            for (int tb = 0; tb < 8; ++tb) acc[db][tb] = (f32x4){0.f, 0.f, 0.f, 0.f};
#pragma unroll
        for (int ks = 0; ks < 4; ++ks) {
            bf16x8 vf[2];
#pragma unroll
            for (int db = 0; db < 2; ++db)
#pragma unroll
                for (int e = 0; e < 8; ++e) vf[db][e] = *(const LAS short*)(Vl + (32 * ks + 8 * fq + e) * 520 + (32 * wave + 16 * db + fr) * 2);
#pragma unroll
            for (int tb = 0; tb < 8; ++tb) {
                if (16 * tb + 15 >= 32 * ks) {
                    const bf16x8 wf = *(const LAS bf16x8*)(Wl + (16 * tb + fr) * 272 + (32 * ks + 8 * fq) * 2);
#pragma unroll
                    for (int db = 0; db < 2; ++db) acc[db][tb] = __builtin_amdgcn_mfma_f32_16x16x32_bf16(vf[db], wf, acc[db][tb], 0, 0, 0);
                }
            }
        }
#pragma unroll
        for (int tb = 0; tb < 8; ++tb) {
            const int t = 16 * tb + fr; const size_t row = (size_t)c * 128 + t; const float bias = sbias[g * 128 + t];
#pragma unroll
            for (int db = 0; db < 2; ++db) {
                const size_t o = row * (2 * DM) + g * 256 + 32 * wave + 16 * db + 4 * fq;
                const u32x2 uu = *(const u32x2*)(xr + o);
                u32x2 w; w[0] = pk2(bflo(uu[0]) * (acc[db][tb][0] + bias), bfhi(uu[0]) * (acc[db][tb][1] + bias)); w[1] = pk2(bflo(uu[1]) * (acc[db][tb][2] + bias), bfhi(uu[1]) * (acc[db][tb][3] + bias));
                *(u32x2*)(xr + o) = w;
            }
        }
    }
    __syncthreads();
}

__device__ void attn_phase(unsigned char* lds_g, const Params& P) {
    LAS unsigned char* lds = (LAS unsigned char*)lds_g;
    const int tid = threadIdx.x, lane = tid & 63, wave = tid >> 6, fr = lane & 15, fq = lane >> 4, G = gridDim.x;
    const bf16_t* q = (const bf16_t*)(P.ws + WS_R1 + 3 * SLOT); bf16_t* o = (bf16_t*)(P.ws + WS_R1 + 4 * SLOT);
    const bf16_t* Kb = (const bf16_t*)(P.ws + WS_KB); const bf16_t* Vt = (const bf16_t*)(P.ws + WS_VT);
    for (int u = blockIdx.x; u < 512; u += G) {
        const int bh = u >> 6, qb = u & 63, b = bh >> 2, h = bh & 3;
        const size_t rowq = (size_t)b * SEQ + qb * 256 + wave * 32 + fr;
        __syncthreads();
#pragma unroll
        for (int i = 0; i < 16; ++i) {
            const int e = tid + NTHR * i, r = e >> 5, cc = e & 31;
            *(LAS u32x4*)(lds + r * 528 + cc * 16) = *(const u32x4*)(Kb + ((size_t)bh * 256 + r) * 256 + cc * 8);
        }
        const bf16_t* qp = q + rowq * DM + h * 256 + fq * 8;
        bf16x8 qn0 = *(const bf16x8*)qp, qn1 = *(const bf16x8*)(qp + 16 * DM);
        __syncthreads();
        f32x4 S[16][2];
#pragma unroll
        for (int kb = 0; kb < 16; ++kb) { S[kb][0] = (f32x4){0.f, 0.f, 0.f, 0.f}; S[kb][1] = (f32x4){0.f, 0.f, 0.f, 0.f}; }
#pragma unroll 1
        for (int ks = 0; ks < 8; ++ks) {
            const bf16x8 q0 = qn0, q1 = qn1;
            const int kn = ks < 7 ? ks + 1 : 7;
            qn0 = *(const bf16x8*)(qp + kn * 32); qn1 = *(const bf16x8*)(qp + 16 * DM + kn * 32);
            const LAS unsigned char* kp = lds + fr * 528 + (32 * ks + 8 * fq) * 2;
#pragma unroll
            for (int kb = 0; kb < 16; ++kb) {
                const bf16x8 kf = *(const LAS bf16x8*)(kp + kb * 16 * 528);
                S[kb][0] = __builtin_amdgcn_mfma_f32_16x16x32_bf16(kf, q0, S[kb][0], 0, 0, 0);
                S[kb][1] = __builtin_amdgcn_mfma_f32_16x16x32_bf16(kf, q1, S[kb][1], 0, 0, 0);
                if ((kb & 3) == 3) __builtin_amdgcn_sched_barrier(0);
            }
        }
        float inv[2];
#pragma unroll
        for (int nb = 0; nb < 2; ++nb) {
            float mx = -3.0e38f;
#pragma unroll
            for (int kb = 0; kb < 16; ++kb) mx = fmaxf(fmaxf(fmaxf(S[kb][nb][0], S[kb][nb][1]), fmaxf(S[kb][nb][2], S[kb][nb][3])), mx);
            mx = fmaxf(mx, __shfl_xor(mx, 16)); mx = fmaxf(mx, __shfl_xor(mx, 32));
            float sum = 0.f;
#pragma unroll
            for (int kb = 0; kb < 16; ++kb)
#pragma unroll
                for (int j = 0; j < 4; ++j) { const float p = __expf(S[kb][nb][j] - mx); S[kb][nb][j] = p; sum += p; }
            sum = xor16_32_sum(sum);
            inv[nb] = 1.0f / sum;
        }
        bf16x8 pf[8][2];
#pragma unroll
        for (int c = 0; c < 8; ++c)
#pragma unroll
            for (int nb = 0; nb < 2; ++nb) {
                u32x4 w; w[0] = pk2(S[2 * c][nb][0], S[2 * c][nb][1]); w[1] = pk2(S[2 * c][nb][2], S[2 * c][nb][3]); w[2] = pk2(S[2 * c + 1][nb][0], S[2 * c + 1][nb][1]); w[3] = pk2(S[2 * c + 1][nb][2], S[2 * c + 1][nb][3]);
                pf[c][nb] = __builtin_bit_cast(bf16x8, w);
            }
        __syncthreads();
        __builtin_amdgcn_sched_barrier(0);
#pragma unroll
        for (int i = 0; i < 16; ++i) {
            const int e = tid + NTHR * i, r = e >> 5, cc = e & 31;
            *(LAS u32x4*)(lds + r * 528 + cc * 16) = *(const u32x4*)(Vt + ((size_t)bh * 256 + r) * 256 + cc * 8);
        }
        __syncthreads();
#pragma unroll 1
        for (int dq = 0; dq < 4; ++dq) {
            const LAS unsigned char* vp = lds + (64 * dq + fr) * 528 + 16 * fq;
            f32x4 O[4][2];
#pragma unroll
            for (int db = 0; db < 4; ++db) { O[db][0] = (f32x4){0.f, 0.f, 0.f, 0.f}; O[db][1] = (f32x4){0.f, 0.f, 0.f, 0.f}; }
#pragma unroll
            for (int db = 0; db < 4; ++db)
#pragma unroll
                for (int c = 0; c < 8; ++c) {
                    const bf16x8 vf = *(const LAS bf16x8*)(vp + db * 16 * 528 + c * 64);
                    O[db][0] = __builtin_amdgcn_mfma_f32_16x16x32_bf16(vf, pf[c][0], O[db][0], 0, 0, 0);
                    O[db][1] = __builtin_amdgcn_mfma_f32_16x16x32_bf16(vf, pf[c][1], O[db][1], 0, 0, 0);
                }
#pragma unroll
            for (int nb = 0; nb < 2; ++nb)
#pragma unroll
                for (int db = 0; db < 4; ++db) {
                    u32x2 w; w[0] = pk2(O[db][nb][0] * inv[nb], O[db][nb][1] * inv[nb]); w[1] = pk2(O[db][nb][2] * inv[nb], O[db][nb][3] * inv[nb]);
                    *(u32x2*)(o + (rowq + nb * 16) * DM + h * 256 + 64 * dq + 16 * db + 4 * fq) = w;
                }
        }
    }
    __syncthreads();
}

template <class Epi> __device__ __forceinline__ void run_gemm(unsigned char* lds, const bf16_t* A, const bf16_t* Bt, int M, int N, int K, const Epi& E) {
    pg8::Gemm g{A, Bt, M, N, K}; pg8::StaticOrder S; S.init(M, N, (int)gridDim.x, (int)blockIdx.x);
    pg8::gemm_phase<Epi, pg8::StaticOrder, true, true>((PG8_LAS unsigned char*)lds, g, S, E);
}

__global__ void __launch_bounds__(NTHR, 2) mega_fwd(Params P) {
    extern __shared__ __attribute__((aligned(16))) unsigned char lds[];
    cg::grid_group grid = cg::this_grid();
    const int lo = P.ph_lo, hi = P.ph_hi;
    unsigned char* ws = P.ws;
    bf16_t* W = (bf16_t*)(ws + WS_W);
    bf16_t* HB = (bf16_t*)(ws + WS_HB);
    bf16_t* S0 = (bf16_t*)(ws + WS_R1), *S1 = (bf16_t*)(ws + WS_R1 + SLOT), *S3 = (bf16_t*)(ws + WS_R1 + 3 * SLOT), *S4 = (bf16_t*)(ws + WS_R1 + 4 * SLOT);
    bf16_t* X = (bf16_t*)P.out;
    float* SS = (float*)(ws + WS_SS); float* VST = (float*)(ws + WS_VST);
#ifndef PHMASK
#define PHMASK 0x1fff
#endif
#define IN(k) (((PHMASK >> (k)) & 1) && lo <= (k) && (k) < hi)
#define SEAM(k) do { if (IN(k) && IN((k) + 1)) grid.sync(); } while (0)
    if (IN(0)) prep_phase(lds, P);
    SEAM(0);
    if (IN(1)) {
        kv_phase(lds, P);
        run_gemm(lds, HB, (const bf16_t*)((unsigned char*)W + OW_GU1), MTOK, 2 * DFF, DM, EpiSwiglu{S0, SS});
    }
    SEAM(1);
    if (IN(2)) run_gemm(lds, S0, (const bf16_t*)((unsigned char*)W + OW_DN1), MTOK, DM, DFF, EpiRes{HB, SS, 0.5f});
    SEAM(2);
    if (IN(3)) run_gemm(lds, HB, (const bf16_t*)((unsigned char*)W + OW_IN), MTOK, DIN, DM, EpiWin{SS, P.in[7], S0, S1, VST, X + DM});
    SEAM(3);
    if (IN(4)) { conv_phase(lds, P); sgu_phase(lds, P); }
    SEAM(4);
    if (IN(5)) run_gemm(lds, X, (const bf16_t*)((unsigned char*)W + OW_A), MTOK, DM, 2 * DM, EpiDual{S3, S4, S1});
    SEAM(5);
    if (IN(6)) run_gemm(lds, S1, (const bf16_t*)((unsigned char*)W + OW_OUT), MTOK, DM, DM, EpiRes{HB, SS, 1.0f});
    SEAM(6);
    if (IN(7)) run_gemm(lds, HB, (const bf16_t*)((unsigned char*)W + OW_Q), MTOK, DM, DM, EpiGate<2>{nullptr, nullptr, S3, SS});
    SEAM(7);
    if (IN(8)) attn_phase(lds, P);
    SEAM(8);
    if (IN(9)) run_gemm(lds, S4, (const bf16_t*)((unsigned char*)W + OW_O), MTOK, DM, DM, EpiRes{HB, SS, 1.0f});
    SEAM(9);
    if (IN(10)) run_gemm(lds, HB, (const bf16_t*)((unsigned char*)W + OW_GU2), MTOK, 2 * DFF, DM, EpiSwiglu{S0, SS});
    SEAM(10);
    if (IN(11)) run_gemm(lds, S0, (const bf16_t*)((unsigned char*)W + OW_DN2), MTOK, DM, DFF, EpiRes{HB, SS, 0.5f});
    SEAM(11);
    if (IN(12)) final_phase(P);
#undef IN
#undef SEAM
}
constexpr int NPHASE = 13;

#ifndef DBL
#define DBL 0
#endif
#ifndef N_LAUNCH_PER_PHASE
#define N_LAUNCH_PER_PHASE 0
#endif

extern "C" void kernel_launch(void* const* d_in, const int* in_sizes, int n_in, void* d_out, int out_size, void* d_ws, size_t ws_size, hipStream_t stream) {
    static int grid_blocks = 0;
    if (!grid_blocks) {
        int dev = 0, cus = 0, per_cu = 0;
        hipGetDevice(&dev);
        hipDeviceGetAttribute(&cus, hipDeviceAttributeMultiprocessorCount, dev);
        hipFuncSetAttribute((const void*)mega_fwd, hipFuncAttributeMaxDynamicSharedMemorySize, LDS_BYTES);
        hipOccupancyMaxActiveBlocksPerMultiprocessor(&per_cu, (const void*)mega_fwd, NTHR, LDS_BYTES);
        if (per_cu < 1) { fprintf(stderr, "occupancy query says %d blocks/CU\n", per_cu); per_cu = 1; }
        grid_blocks = cus * per_cu;
        if (ws_size < WS_END || n_in != 28) fprintf(stderr, "unexpected ws_size %zu / n_in %d\n", ws_size, n_in);
    }
    Params p;
    memset(&p, 0, sizeof(p));
    for (int i = 0; i < 28; ++i) p.in[i] = (const float*)d_in[i];
    p.out = (float*)d_out; p.ws = (unsigned char*)d_ws;
    unsigned char* W = (unsigned char*)d_ws + WS_W;
    auto setw = [&](int i, int src, size_t off, int K, int Nsrc, int Nout, int mode, int ksc, float csc) {
        p.wd[i].src = (const float*)d_in[src]; p.wd[i].dst = (bf16_t*)(W + off); p.wd[i].ksc = ksc >= 0 ? (const float*)d_in[ksc] : nullptr;
        p.wd[i].K = K; p.wd[i].Nsrc = Nsrc; p.wd[i].Nout = Nout; p.wd[i].mode = mode; p.wd[i].csc = csc; p.wd[i].ldd = K; };
    setw(0, 3, OW_GU1, 1024, 5632, 5632, 1, 2, 1.0f);
    setw(1, 4, OW_DN1, 2816, 1024, 1024, 0, -1, 1.0f);
    setw(2, 6, OW_IN, 1024, 6144, 6144, 2, 5, 1.0f);
    setw(3, 12, OW_A, 1024, 1024, 1024, 0, -1, 1.0f);
    setw(4, 17, OW_A + 2048, 1024, 1024, 1024, 0, -1, 1.0f);
    p.wd[3].ldd = 2048; p.wd[4].ldd = 2048;
    setw(5, 18, OW_OUT, 1024, 1024, 1024, 0, -1, 1.0f);
    setw(6, 21, OW_Q, 1024, 1024, 1024, 0, 19, 0.0625f);
    setw(7, 23, OW_O, 1024, 1024, 1024, 0, -1, 1.0f);
    setw(8, 22, OW_KV, 1024, 2048, 2048, 0, -1, 1.0f);
    setw(9, 25, OW_GU2, 1024, 5632, 5632, 1, 24, 1.0f);
    setw(10, 26, OW_DN2, 2816, 1024, 1024, 0, -1, 1.0f);
#if N_LAUNCH_PER_PHASE
    for (int ph = 0; ph < NPHASE; ++ph) {
        p.ph_lo = ph; p.ph_hi = ph + 1;
        for (int r = 0; r <= ((DBL >> ph) & 1); ++r) hipLaunchKernelGGL(mega_fwd, dim3(grid_blocks), dim3(NTHR), LDS_BYTES, stream, p);
    }
#else
    p.ph_lo = 0; p.ph_hi = NPHASE;
    void* args[] = {&p};
    hipError_t e = hipLaunchCooperativeKernel((const void*)mega_fwd, dim3(grid_blocks), dim3(NTHR), args, LDS_BYTES, stream);
    if (e != hipSuccess) fprintf(stderr, "cooperative launch failed: %s (grid %d)\n", hipGetErrorString(e), grid_blocks);
#endif
}
```

```cpp
#include <hip/hip_runtime.h>
#include <hip/hip_cooperative_groups.h>
#include <cstdio>
namespace cg = cooperative_groups;

#include <cstring>
#include <utility>
namespace pg8 {
#define PG8_LAS __attribute__((address_space(3)))
typedef unsigned short bf16_t;
typedef short bf16x8 __attribute__((ext_vector_type(8)));
typedef float f32x4 __attribute__((ext_vector_type(4)));
typedef unsigned u32x4 __attribute__((ext_vector_type(4)));
constexpr int BM = 256, BK = 64, HALF = 128, HTB = HALF * BK * 2  , STAGE_BYTES = 8 * HTB, NXCD = 8, WGM = 8;

__host__ __device__ __forceinline__ int lds_byte(int r, int c) { const int st = (r >> 4) * 2 + (c >> 5), rr = r & 15, cc = c & 31, ob = rr * 64 + cc * 2; return st * 1024 + (ob ^ (((ob >> 9) & 1) << 5)); }
__host__ __device__ __forceinline__ void stage_rc(int b, int& R, int& C) { const int st = b / 1024, sb = b % 1024, swz = sb ^ (((sb >> 9) & 1) << 5); R = (st >> 1) * 16 + swz / 64; C = (st & 1) * 32 + (swz % 64) / 2; }
__host__ __device__ __forceinline__ int perm32(int rho) { const int n = rho >> 4, i = rho & 15; return 8 * (i >> 2) + 4 * n + (i & 3); }

struct Unit { int pm, pn; };
struct Gemm { const bf16_t* A; const bf16_t* Bt; int M, N, K; };

struct StaticOrder {
    int nM, nN, nwg, G, c;
    __host__ __device__ void init(int M, int N, int G_, int c_) { nM = M / BM; nN = N / BM; nwg = nM * nN; G = G_; c = c_; }
    __host__ __device__ bool next(int i, Unit& u) const {
        const long L = (long)i * G + c; if (L >= nwg) return false;
        int wgid = (int)L; { const int q = nwg / NXCD, r = nwg % NXCD, xcd = wgid % NXCD, off = wgid / NXCD; wgid = (xcd < r ? xcd * (q + 1) : r * (q + 1) + (xcd - r) * q) + off; }
        const int nig = WGM * nN, gid = wgid / nig, fm = gid * WGM, gsz = (nM - fm) < WGM ? (nM - fm) : WGM;
        u.pm = fm + ((wgid % nig) % gsz); u.pn = (wgid % nig) / gsz; return true;
    }
    __device__ __forceinline__ void a_ready(const Unit&) const {}
    __device__ __forceinline__ void done(const Unit&) const {}
};

template <class Epi, class Sched, bool ALIGN_EPI = false, bool SP2 = false>
__device__ __forceinline__ void gemm_phase(PG8_LAS unsigned char* lds, const Gemm g, const Sched& S, const Epi& E) {
    const int tid = threadIdx.x, wid = __builtin_amdgcn_readfirstlane(tid >> 6), lane = tid & 63, wr = wid >> 2, wc = wid & 3, fr = lane & 15, fq = lane >> 4;
    const int K = g.K, nt = K / BK;
    unsigned voffA[2], voffB[2];
#pragma unroll
    for (int i = 0; i < 2; ++i) { int R, C; stage_rc(tid * 16 + i * 8192, R, C); const int Rb = Epi::PERM ? ((R & ~31) + perm32(R & 31)) : R;
        voffA[i] = (unsigned)(R * K + C) * 2u; voffB[i] = (unsigned)(Rb * K + C) * 2u; }
    const size_t kstep = (size_t)(BK * 2);
    const size_t hstep = (size_t)HALF * K * 2;
    const size_t tstep = 2 * hstep;
    const unsigned ldsw = (unsigned)wid * 1024u;
    const int aoff = lds_byte(wr * 64 + fr, fq * 8), boff = lds_byte(wc * 32 + fr, fq * 8);
#define PG8_SA(b, h) (((b) * 2 + (h)) * HTB)
#define PG8_SB(b, h) ((4 + (b) * 2 + (h)) * HTB)
#define PG8_STAGE(bufoff, gbase, voff) do { _Pragma("unroll") for (int _i = 0; _i < 2; ++_i) \
        __builtin_amdgcn_global_load_lds((const unsigned*)((const char*)(gbase) + (voff)[_i]), (PG8_LAS unsigned*)(lds + (bufoff) + ldsw + _i * 8192), 16, 0, 0); } while (0)
#define PG8_LDA(dst, b, h) do { _Pragma("unroll") for (int m = 0; m < 4; ++m) _Pragma("unroll") for (int k = 0; k < 2; ++k) dst[m][k] = *(const PG8_LAS bf16x8*)(lds + PG8_SA(b, h) + aoff + m * 2048 + k * 1024); } while (0)
#define PG8_LDB(dst, b, h) do { _Pragma("unroll") for (int n = 0; n < 2; ++n) _Pragma("unroll") for (int k = 0; k < 2; ++k) dst[n][k] = *(const PG8_LAS bf16x8*)(lds + PG8_SB(b, h) + boff + n * 2048 + k * 1024); } while (0)
#define PG8_MMA(ai, bj, At, Bt) do { __builtin_amdgcn_s_setprio(1); _Pragma("unroll") for (int m = 0; m < 4; ++m) _Pragma("unroll") for (int n = 0; n < 2; ++n) _Pragma("unroll") for (int k = 0; k < 2; ++k) \
        acc[ai][bj][m][n] = __builtin_amdgcn_mfma_f32_16x16x32_bf16(Bt[n][k], At[m][k], acc[ai][bj][m][n], 0, 0, 0); __builtin_amdgcn_s_setprio(0); } while (0)
#define PG8_WAIT_V(n) asm volatile("s_waitcnt vmcnt(" #n ")" ::: "memory")
#define PG8_WAIT_L(n) asm volatile("s_waitcnt lgkmcnt(" #n ")" ::: "memory")
#define PG8_BAR __builtin_amdgcn_s_barrier()
#define PG8_SCHED __builtin_amdgcn_sched_barrier(0)
    Unit cur, nxt; int ui = 0;
    if (!S.next(0, cur)) return;
    f32x4 acc[2][2][4][2];
#pragma unroll
    for (int a = 0; a < 2; ++a)
#pragma unroll
        for (int b = 0; b < 2; ++b)
#pragma unroll
            for (int m = 0; m < 4; ++m)
#pragma unroll
                for (int n = 0; n < 2; ++n) acc[a][b][m][n] = (f32x4){0.f, 0.f, 0.f, 0.f};
    bf16x8 At[4][2], B0[2][2], B1[2][2];
    const char* cA = (const char*)g.A + (size_t)cur.pm * tstep; const char* cB = (const char*)g.Bt + (size_t)cur.pn * tstep;
    S.a_ready(cur);
    if constexpr (SP2) {
        PG8_STAGE(PG8_SB(0, 0), cB, voffB); PG8_STAGE(PG8_SB(0, 1), cB + hstep, voffB); PG8_STAGE(PG8_SA(0, 0), cA, voffA); PG8_STAGE(PG8_SA(0, 1), cA + hstep, voffA);
        if (wr == 1) PG8_BAR;
        PG8_WAIT_V(2); PG8_BAR;
        PG8_STAGE(PG8_SB(1, 0), cB + kstep, voffB); PG8_STAGE(PG8_SA(1, 0), cA + kstep, voffA); PG8_STAGE(PG8_SB(1, 1), cB + hstep + kstep, voffB);
        PG8_WAIT_V(6); PG8_BAR;
    } else {
        PG8_STAGE(PG8_SB(0, 0), cB, voffB); PG8_STAGE(PG8_SA(0, 0), cA, voffA); PG8_STAGE(PG8_SB(0, 1), cB + hstep, voffB); PG8_STAGE(PG8_SA(0, 1), cA + hstep, voffA);
        if (wr == 1) PG8_BAR;
        PG8_WAIT_V(4); PG8_BAR;
        PG8_STAGE(PG8_SB(1, 0), cB + kstep, voffB); PG8_STAGE(PG8_SA(1, 0), cA + kstep, voffA); PG8_STAGE(PG8_SB(1, 1), cB + hstep + kstep, voffB);
        PG8_WAIT_V(6); PG8_BAR;
    }
    for (;;) {
        const bool has_next = S.next(ui + 1, nxt);
        const char* nA = has_next ? (const char*)g.A + (size_t)nxt.pm * tstep : cA; const char* nB = has_next ? (const char*)g.Bt + (size_t)nxt.pn * tstep : cB;
        for (int t = 0; t < nt; t += 2) {
            const bool last = (t == nt - 2);
            const char* a1 = cA + (size_t)(t + 1) * kstep;
            const char* a2 = last ? nA : cA + (size_t)(t + 2) * kstep; const char* b2 = last ? nB : cB + (size_t)(t + 2) * kstep;
            const char* a3 = a2 + kstep; const char* b3 = b2 + kstep;
            if (last && has_next) S.a_ready(nxt);
            if constexpr (Epi::MIDK) { if (t == (nt >> 1)) E.mid(acc, cur, wr, wc, fr, fq); }
            if constexpr (SP2) {
            PG8_LDB(B0, 0, 0); PG8_LDB(B1, 0, 1); PG8_SCHED; PG8_LDA(At, 0, 0); PG8_STAGE(PG8_SA(1, 1), a1 + hstep, voffA);
            PG8_WAIT_V(8); PG8_WAIT_L(0); PG8_BAR; PG8_MMA(0, 0, At, B0); PG8_MMA(0, 1, At, B1); PG8_BAR; PG8_SCHED;
            PG8_LDA(At, 0, 1); PG8_STAGE(PG8_SB(0, 0), b2, voffB); PG8_STAGE(PG8_SB(0, 1), b2 + hstep, voffB); PG8_STAGE(PG8_SA(0, 0), a2, voffA);
            PG8_WAIT_V(8); PG8_WAIT_L(0); PG8_BAR; PG8_MMA(1, 0, At, B0); PG8_MMA(1, 1, At, B1); PG8_BAR; PG8_SCHED;
            PG8_LDB(B0, 1, 0); PG8_LDB(B1, 1, 1); PG8_SCHED; PG8_LDA(At, 1, 0); PG8_STAGE(PG8_SA(0, 1), a2 + hstep, voffA);
            PG8_WAIT_V(8); PG8_WAIT_L(0); PG8_BAR; PG8_MMA(0, 0, At, B0); PG8_MMA(0, 1, At, B1); PG8_BAR; PG8_SCHED;
            PG8_LDA(At, 1, 1); PG8_STAGE(PG8_SB(1, 0), b3, voffB); PG8_STAGE(PG8_SB(1, 1), b3 + hstep, voffB); PG8_STAGE(PG8_SA(1, 0), a3, voffA);
            PG8_WAIT_V(8); PG8_WAIT_L(0); PG8_BAR; PG8_MMA(1, 0, At, B0); PG8_MMA(1, 1, At, B1); PG8_BAR; PG8_SCHED;
            } else {
            PG8_LDB(B0, 0, 0); PG8_SCHED; PG8_LDA(At, 0, 0); PG8_STAGE(PG8_SA(1, 1), a1 + hstep, voffA);
            PG8_WAIT_L(8); PG8_BAR; PG8_WAIT_L(0); PG8_MMA(0, 0, At, B0); PG8_BAR; PG8_SCHED;
            PG8_LDB(B1, 0, 1); PG8_STAGE(PG8_SB(0, 0), b2, voffB);
            PG8_BAR; PG8_WAIT_L(0); PG8_MMA(0, 1, At, B1); PG8_BAR;
            PG8_LDA(At, 0, 1); PG8_STAGE(PG8_SA(0, 0), a2, voffA);
            PG8_BAR; PG8_WAIT_L(0); PG8_MMA(1, 0, At, B0); PG8_BAR; PG8_SCHED;
            PG8_STAGE(PG8_SB(0, 1), b2 + hstep, voffB);
            PG8_WAIT_V(6); PG8_BAR; PG8_MMA(1, 1, At, B1); PG8_BAR;
            PG8_LDB(B0, 1, 0); PG8_SCHED; PG8_LDA(At, 1, 0); PG8_STAGE(PG8_SA(0, 1), a2 + hstep, voffA);
            PG8_WAIT_L(8); PG8_BAR; PG8_WAIT_L(0); PG8_MMA(0, 0, At, B0); PG8_BAR; PG8_SCHED;
            PG8_LDB(B1, 1, 1); PG8_STAGE(PG8_SB(1, 0), b3, voffB);
            PG8_BAR; PG8_WAIT_L(0); PG8_MMA(0, 1, At, B1); PG8_BAR;
            PG8_LDA(At, 1, 1); PG8_STAGE(PG8_SA(1, 0), a3, voffA);
            PG8_BAR; PG8_WAIT_L(0); PG8_MMA(1, 0, At, B0); PG8_BAR; PG8_SCHED;
            PG8_STAGE(PG8_SB(1, 1), b3 + hstep, voffB);
            PG8_WAIT_V(6); PG8_BAR; PG8_MMA(1, 1, At, B1); PG8_BAR;
            }
        }
        if constexpr (ALIGN_EPI) { if (wr == 0) PG8_BAR; }
        if constexpr (!Epi::AFTER_DRAIN) { E(acc, cur, wr, wc, fr, fq); S.done(cur); }
        if (!has_next) break;
#pragma unroll
        for (int a = 0; a < 2; ++a)
#pragma unroll
            for (int b = 0; b < 2; ++b)
#pragma unroll
                for (int m = 0; m < 4; ++m)
#pragma unroll
                    for (int n = 0; n < 2; ++n) acc[a][b][m][n] = (f32x4){0.f, 0.f, 0.f, 0.f};
        cur = nxt; cA = nA; cB = nB; ++ui;
        if constexpr (ALIGN_EPI) { if (wr == 1) PG8_BAR; }
    }
    PG8_WAIT_V(0);
    if constexpr (!ALIGN_EPI) { if (wr == 0) PG8_BAR; }
    PG8_BAR;
    if constexpr (Epi::AFTER_DRAIN) { E.fused(acc, cur, wr, wc, fr, fq, lds, wid, lane); S.done(cur); }
#undef PG8_SA
#undef PG8_SB
#undef PG8_STAGE
#undef PG8_LDA
#undef PG8_LDB
#undef PG8_MMA
#undef PG8_WAIT_V
#undef PG8_WAIT_L
#undef PG8_BAR
#undef PG8_SCHED
}
}

using pg8::bf16_t; using pg8::bf16x8; using pg8::f32x4; using pg8::u32x4; using pg8::Unit;
#define LAS __attribute__((address_space(3)))
typedef unsigned u32x2 __attribute__((ext_vector_type(2)));
typedef float f32x2 __attribute__((ext_vector_type(2)));

constexpr int MTOK = 32768, DM = 1024, DFF = 2816, SEQ = 16384, NMEM = 256, DIN = 6144;
constexpr int NTHR = 512;
constexpr size_t MiB = 1024 * 1024;
constexpr size_t WS_W = 0;
constexpr size_t OW_GU1 = 0, OW_DN1 = OW_GU1 + (size_t)5632 * 1024 * 2, OW_IN = OW_DN1 + (size_t)1024 * 2816 * 2, OW_A = OW_IN + (size_t)6144 * 1024 * 2,
                 OW_B = OW_A + 2 * MiB, OW_OUT = OW_B + 2 * MiB, OW_Q = OW_OUT + 2 * MiB, OW_O = OW_Q + 2 * MiB, OW_KV = OW_O + 2 * MiB,
                 OW_GU2 = OW_KV + 4 * MiB, OW_DN2 = OW_GU2 + (size_t)5632 * 1024 * 2, OW_END = OW_DN2 + (size_t)1024 * 2816 * 2;
static_assert(OW_END <= 64 * MiB, "weights region");
constexpr size_t WS_HB = 64 * MiB;
constexpr size_t WS_R1 = 128 * MiB;
constexpr size_t SLOT = 64 * MiB;
constexpr size_t WS_SS = 448 * MiB;
constexpr size_t WS_VST = 450 * MiB;
constexpr size_t WS_KB = 454 * MiB;
constexpr size_t WS_VT = 455 * MiB;
constexpr size_t WS_MEMN = 456 * MiB;
constexpr size_t WS_BAR = 457 * MiB;
constexpr size_t WS_END = 458 * MiB;
constexpr int LDS_IMG = 256 * 528;
constexpr int LDS_BYTES = LDS_IMG + 64;

struct WDesc { const float* src; bf16_t* dst; const float* ksc; int K, Nsrc, Nout, mode; float csc; int ldd; };
struct Params {
    const float* in[28]; float* out; unsigned char* ws;
    WDesc wd[11];
    int ph_lo, ph_hi;
};

__device__ __forceinline__ unsigned pk2(float lo, float hi) { unsigned r; asm volatile("v_cvt_pk_bf16_f32 %0, %1, %2" : "=v"(r) : "v"(lo), "v"(hi)); return r; }
__device__ __forceinline__ float bflo(unsigned w) { return __uint_as_float(w << 16); }
__device__ __forceinline__ float bfhi(unsigned w) { return __uint_as_float(w & 0xffff0000u); }
__device__ __forceinline__ float fsigmoid(float x) { return __builtin_amdgcn_rcpf(1.0f + __expf(-x)); }
__device__ __forceinline__ float fsilu(float x) { return x * fsigmoid(x); }
__device__ __forceinline__ float fgelu(float x) { return x * fsigmoid(1.5957691216057308f * (x + 0.044715f * x * x * x)); }
__device__ __forceinline__ float row_rs(const float* ss, int row) {
    const f32x4* p = (const f32x4*)(ss + (size_t)row * 16);
    const f32x4 a = p[0], b = p[1], c = p[2], d = p[3];
    const float s = ((a[0] + a[1]) + (a[2] + a[3])) + ((b[0] + b[1]) + (b[2] + b[3])) + ((c[0] + c[1]) + (c[2] + c[3])) + ((d[0] + d[1]) + (d[2] + d[3]));
    return rsqrtf(s * (1.0f / 1024.0f) + 1e-6f);
}
__device__ __forceinline__ float xor16_32_sum(float v) { v += __shfl_xor(v, 16); v += __shfl_xor(v, 32); return v; }

struct EpiSwiglu {
    static constexpr bool PERM = true, AFTER_DRAIN = false, MIDK = false;
    bf16_t* out; const float* ss;
    __device__ __forceinline__ void operator()(const f32x4 (&acc)[2][2][4][2], const Unit& u, int wr, int wc, int fr, int fq) const {
        const int row0 = u.pm * 256 + wr * 64 + fr, col0 = u.pn * 128 + wc * 32 + 8 * fq;
#pragma unroll
        for (int ai = 0; ai < 2; ++ai)
#pragma unroll
            for (int m = 0; m < 4; ++m) {
                const int row = row0 + ai * 128 + m * 16; const float r = row_rs(ss, row);
                u32x4 w;
#pragma unroll
                for (int n = 0; n < 2; ++n)
#pragma unroll
                    for (int jj = 0; jj < 2; ++jj) {
                        const float g0 = r * acc[ai][0][m][n][2 * jj], g1 = r * acc[ai][0][m][n][2 * jj + 1];
                        const float u0 = r * acc[ai][1][m][n][2 * jj], u1 = r * acc[ai][1][m][n][2 * jj + 1];
                        w[n * 2 + jj] = pk2(fsilu(g0) * u0, fsilu(g1) * u1);
                    }
                *(u32x4*)(out + (size_t)row * DFF + col0) = w;
            }
    }
};
struct EpiRes {
    static constexpr bool PERM = true, AFTER_DRAIN = false, MIDK = false;
    bf16_t* h; float* ss; float scale;
    __device__ __forceinline__ void operator()(const f32x4 (&acc)[2][2][4][2], const Unit& u, int wr, int wc, int fr, int fq) const {
        const int row0 = u.pm * 256 + wr * 64 + fr, col0 = u.pn * 256 + wc * 32 + 8 * fq;
#pragma unroll
        for (int ai = 0; ai < 2; ++ai)
#pragma unroll
            for (int m = 0; m < 4; ++m) {
                const int row = row0 + ai * 128 + m * 16; float sq = 0.f;
#pragma unroll
                for (int bj = 0; bj < 2; ++bj) {
                    const size_t o = (size_t)row * DM + col0 + bj * 128;
                    const u32x4 x = *(const u32x4*)(h + o);
                    f32x4 x0, x1; x0[0] = bflo(x[0]); x0[1] = bfhi(x[0]); x0[2] = bflo(x[1]); x0[3] = bfhi(x[1]); x1[0] = bflo(x[2]); x1[1] = bfhi(x[2]); x1[2] = bflo(x[3]); x1[3] = bfhi(x[3]);
                    const f32x4 v0 = x0 + scale * acc[ai][bj][m][0], v1 = x1 + scale * acc[ai][bj][m][1];
                    sq += (v0[0] * v0[0] + v0[1] * v0[1]) + (v0[2] * v0[2] + v0[3] * v0[3]) + (v1[0] * v1[0] + v1[1] * v1[1]) + (v1[2] * v1[2] + v1[3] * v1[3]);
                    u32x4 w; w[0] = pk2(v0[0], v0[1]); w[1] = pk2(v0[2], v0[3]); w[2] = pk2(v1[0], v1[1]); w[3] = pk2(v1[2], v1[3]); *(u32x4*)(h + o) = w;
                }
                sq = xor16_32_sum(sq);
                if (fq == 0) ss[(size_t)row * 16 + u.pn * 4 + wc] = sq;
            }
    }
};
struct EpiWin {
    static constexpr bool PERM = true, AFTER_DRAIN = false, MIDK = false;
    const float* ss; const float* bias; bf16_t* a_out; bf16_t* g_out; float* vst; bf16_t* xr;
    __device__ __forceinline__ void operator()(const f32x4 (&acc)[2][2][4][2], const Unit& u, int wr, int wc, int fr, int fq) const {
        const int row0 = u.pm * 256 + wr * 64 + fr; const int pn = u.pn;
        if (pn < 8) {
            const int col0 = pn * 128 + wc * 32 + 8 * fq;
            const f32x4 bv0 = *(const f32x4*)(bias + col0), bv1 = *(const f32x4*)(bias + col0 + 4), bg0 = *(const f32x4*)(bias + 1024 + col0), bg1 = *(const f32x4*)(bias + 1024 + col0 + 4);
#pragma unroll
            for (int ai = 0; ai < 2; ++ai)
#pragma unroll
                for (int m = 0; m < 4; ++m) {
                    const int row = row0 + ai * 128 + m * 16; const float r = row_rs(ss, row);
                    const f32x4 v0 = r * acc[ai][0][m][0] + bv0, v1 = r * acc[ai][0][m][1] + bv1, g0 = r * acc[ai][1][m][0] + bg0, g1 = r * acc[ai][1][m][1] + bg1;
                    u32x4 w;
                    w[0] = pk2(v0[0] * fsigmoid(g0[0]), v0[1] * fsigmoid(g0[1])); w[1] = pk2(v0[2] * fsigmoid(g0[2]), v0[3] * fsigmoid(g0[3]));
                    w[2] = pk2(v1[0] * fsigmoid(g1[0]), v1[1] * fsigmoid(g1[1])); w[3] = pk2(v1[2] * fsigmoid(g1[2]), v1[3] * fsigmoid(g1[3]));
                    *(u32x4*)(a_out + (size_t)row * DM + col0) = w;
                }
        } else {
            const int idx = (pn - 8) >> 2; const int cb = ((pn - 8) & 3) * 256 + wc * 32 + 8 * fq;
            bf16_t* ob = idx == 0 ? xr : g_out + (size_t)idx * MTOK * DM; const int ldo = idx == 0 ? 2 * DM : DM;
            f32x4 b[2][2];
#pragma unroll
            for (int bj = 0; bj < 2; ++bj) { b[bj][0] = *(const f32x4*)(bias + 2048 + idx * 1024 + cb + bj * 128); b[bj][1] = *(const f32x4*)(bias + 2048 + idx * 1024 + cb + bj * 128 + 4); }
#pragma unroll
            for (int ai = 0; ai < 2; ++ai)
#pragma unroll
                for (int m = 0; m < 4; ++m) {
                    const int row = row0 + ai * 128 + m * 16; const float r = row_rs(ss, row);
                    float s1 = 0.f, s2 = 0.f;
#pragma unroll
                    for (int bj = 0; bj < 2; ++bj) {
                        f32x4 v0 = r * acc[ai][bj][m][0] + b[bj][0], v1 = r * acc[ai][bj][m][1] + b[bj][1];
                        if (idx < 2) {
#pragma unroll
                            for (int j = 0; j < 4; ++j) { v0[j] = fgelu(v0[j]); v1[j] = fgelu(v1[j]); }
                        } else {
#pragma unroll
                            for (int j = 0; j < 4; ++j) { v0[j] = fsigmoid(v0[j]); v1[j] = fsigmoid(v1[j]); }
                        }
                        s1 += (v0[0] + v0[1]) + (v0[2] + v0[3]) + (v1[0] + v1[1]) + (v1[2] + v1[3]);
                        s2 += (v0[0] * v0[0] + v0[1] * v0[1]) + (v0[2] * v0[2] + v0[3] * v0[3]) + (v1[0] * v1[0] + v1[1] * v1[1]) + (v1[2] * v1[2] + v1[3] * v1[3]);
                        u32x4 w; w[0] = pk2(v0[0], v0[1]); w[1] = pk2(v0[2], v0[3]); w[2] = pk2(v1[0], v1[1]); w[3] = pk2(v1[2], v1[3]);
                        *(u32x4*)(ob + (size_t)row * ldo + cb + bj * 128) = w;
                    }
                    if (idx == 1) {
                        s1 = xor16_32_sum(s1); s2 = xor16_32_sum(s2);
                        if (fq == 0) { f32x2 st; st[0] = s1; st[1] = s2; *(f32x2*)(vst + ((size_t)row * 16 + (pn - 12) * 4 + wc) * 2) = st; }
                    }
                }
        }
    }
};
struct EpiDual {
    static constexpr bool PERM = true, AFTER_DRAIN = false, MIDK = true;
    const bf16_t* sga; const bf16_t* sgb; bf16_t* ob;
    __device__ __forceinline__ void mid(f32x4 (&acc)[2][2][4][2], const Unit& u, int wr, int wc, int fr, int fq) const {
        int row0 = u.pm * 256 + wr * 64 + fr; const int col0 = u.pn * 256 + wc * 32 + 8 * fq;
        asm volatile("" : "+v"(row0));
#pragma unroll
        for (int ai = 0; ai < 2; ++ai)
#pragma unroll
            for (int m = 0; m < 4; ++m)
#pragma unroll
                for (int bj = 0; bj < 2; ++bj) {
                    const size_t o = (size_t)(row0 + ai * 128 + m * 16) * DM + col0 + bj * 128;
                    const u32x4 ga = *(const u32x4*)(sga + o), gb = *(const u32x4*)(sgb + o);
#pragma unroll
                    for (int e = 0; e < 4; ++e) {
                        const float r0 = bflo(ga[e]) * __builtin_amdgcn_rcpf(bflo(gb[e])), r1 = bfhi(ga[e]) * __builtin_amdgcn_rcpf(bfhi(gb[e]));
                        acc[ai][bj][m][e >> 1][(e & 1) * 2] *= r0; acc[ai][bj][m][e >> 1][(e & 1) * 2 + 1] *= r1;
                    }
                    if (bj == 1 && (m & 1)) __builtin_amdgcn_sched_barrier(0);
                }
    }
    __device__ __forceinline__ void operator()(const f32x4 (&acc)[2][2][4][2], const Unit& u, int wr, int wc, int fr, int fq) const {
        const int row0 = u.pm * 256 + wr * 64 + fr, col0 = u.pn * 256 + wc * 32 + 8 * fq;
#pragma unroll
        for (int ai = 0; ai < 2; ++ai)
#pragma unroll
            for (int m = 0; m < 4; ++m)
#pragma unroll
                for (int bj = 0; bj < 2; ++bj) {
                    const size_t o = (size_t)(row0 + ai * 128 + m * 16) * DM + col0 + bj * 128;
                    const u32x4 gb = *(const u32x4*)(sgb + o);
                    const f32x4 a0 = acc[ai][bj][m][0], a1 = acc[ai][bj][m][1];
                    u32x4 w; w[0] = pk2(a0[0] * bflo(gb[0]), a0[1] * bfhi(gb[0])); w[1] = pk2(a0[2] * bflo(gb[1]), a0[3] * bfhi(gb[1]));
                    w[2] = pk2(a1[0] * bflo(gb[2]), a1[1] * bfhi(gb[2])); w[3] = pk2(a1[2] * bflo(gb[3]), a1[3] * bfhi(gb[3]));
                    *(u32x4*)(ob + o) = w;
                }
    }
};
template <int MODE> struct EpiGate {
    static constexpr bool PERM = true, AFTER_DRAIN = false, MIDK = false;
    const bf16_t* sg; float* ya; bf16_t* ob; const float* ss;
    __device__ __forceinline__ void operator()(const f32x4 (&acc)[2][2][4][2], const Unit& u, int wr, int wc, int fr, int fq) const {
        const int row0 = u.pm * 256 + wr * 64 + fr, col0 = u.pn * 256 + wc * 32 + 8 * fq;
#pragma unroll
        for (int ai = 0; ai < 2; ++ai)
#pragma unroll
            for (int m = 0; m < 4; ++m) {
                const int row = row0 + ai * 128 + m * 16;
                float r = 1.f; if (MODE == 2) r = row_rs(ss, row);
#pragma unroll
                for (int bj = 0; bj < 2; ++bj) {
                    const size_t o = (size_t)row * DM + col0 + bj * 128;
                    f32x4 v0, v1;
                    if (MODE == 2) { v0 = r * acc[ai][bj][m][0]; v1 = r * acc[ai][bj][m][1]; }
                    else {
                        const u32x4 g = *(const u32x4*)(sg + o);
                        f32x4 s0, s1; s0[0] = bflo(g[0]); s0[1] = bfhi(g[0]); s0[2] = bflo(g[1]); s0[3] = bfhi(g[1]); s1[0] = bflo(g[2]); s1[1] = bfhi(g[2]); s1[2] = bflo(g[3]); s1[3] = bfhi(g[3]);
                        v0 = s0 * acc[ai][bj][m][0]; v1 = s1 * acc[ai][bj][m][1];
                        if (MODE == 1) { v0 += *(const f32x4*)(ya + o); v1 += *(const f32x4*)(ya + o + 4); }
                    }
                    if (MODE == 0) { *(f32x4*)(ya + o) = v0; *(f32x4*)(ya + o + 4) = v1; }
                    else { u32x4 w; w[0] = pk2(v0[0], v0[1]); w[1] = pk2(v0[2], v0[3]); w[2] = pk2(v1[0], v1[1]); w[3] = pk2(v1[2], v1[3]); *(u32x4*)(ob + o) = w; }
                }
            }
    }
};
__device__ __forceinline__ int vpos(int m) { return (m & ~31) | (((m >> 2) & 3) << 3) | (((m >> 4) & 1) << 2) | (m & 3); }
__device__ __forceinline__ int wmap(int mode, int n) {
    if (mode == 1) { const int p = n >> 8, bj = (n >> 7) & 1, c = n & 127; return bj * DFF + p * 128 + c; }
    if (mode == 2) { const int p = n >> 8; if (p < 8) { const int bj = (n >> 7) & 1, c = n & 127; return bj * 1024 + p * 128 + c; } return n; }
    return n;
}
__device__ void prep_phase(unsigned char* lds_g, const Params& P) {
    float* tile = (float*)lds_g;
    const int tid = threadIdx.x, G = gridDim.x;
    for (int d = 0; d < 11; ++d) {
        const WDesc w = P.wd[d];
        const int nkt = w.K / 64, ntl = nkt * (w.Nout / 64);
        for (int t = blockIdx.x; t < ntl; t += G) {
            const int kt = t % nkt, nb = t / nkt, k0 = kt * 64, n0 = nb * 64;
            const int sc0 = wmap(w.mode, n0);
            const int tk = tid >> 4, tn = (tid & 15) * 4;
#pragma unroll
            for (int i = 0; i < 2; ++i) {
                const int k = k0 + tk + 32 * i;
                f32x4 v = *(const f32x4*)(w.src + (size_t)k * w.Nsrc + sc0 + tn);
                const float sc = w.csc * (w.ksc ? w.ksc[k] : 1.0f);
                float* tp = tile + (tk + 32 * i) * 65 + tn;
                tp[0] = v[0] * sc; tp[1] = v[1] * sc; tp[2] = v[2] * sc; tp[3] = v[3] * sc;
            }
            __syncthreads();
            const int n = tid >> 3, kq = (tid & 7) * 8;
            u32x4 o;
#pragma unroll
            for (int e = 0; e < 4; ++e) o[e] = pk2(tile[(kq + 2 * e) * 65 + n], tile[(kq + 2 * e + 1) * 65 + n]);
            *(u32x4*)(w.dst + (size_t)(n0 + n) * w.ldd + k0 + kq) = o;
            __syncthreads();
        }
    }
    const int lane = tid & 63, gw = blockIdx.x * 8 + (tid >> 6), nw = G * 8;
    const float* x = P.in[0]; bf16_t* xb = (bf16_t*)(P.ws + WS_HB); float* ss = (float*)(P.ws + WS_SS);
    for (int row = gw; row < MTOK; row += nw) {
        float sq = 0.f;
#pragma unroll
        for (int i = 0; i < 4; ++i) {
            const f32x4 v = *(const f32x4*)(x + (size_t)row * DM + i * 256 + lane * 4);
            sq += (v[0] * v[0] + v[1] * v[1]) + (v[2] * v[2] + v[3] * v[3]);
            u32x2 o; o[0] = pk2(v[0], v[1]); o[1] = pk2(v[2], v[3]);
            *(u32x2*)(xb + (size_t)row * DM + i * 256 + lane * 4) = o;
        }
#pragma unroll
        for (int s = 1; s < 64; s <<= 1) sq += __shfl_xor(sq, s);
        if (lane < 16) ss[(size_t)row * 16 + lane] = lane == 0 ? sq : 0.f;
    }
    const float* mem = P.in[1]; const float* mg = P.in[20]; bf16_t* memn = (bf16_t*)(P.ws + WS_MEMN);
    for (int row = gw; row < 2 * NMEM; row += nw) {
        f32x4 v[4]; float sq = 0.f;
#pragma unroll
        for (int i = 0; i < 4; ++i) { v[i] = *(const f32x4*)(mem + (size_t)row * DM + i * 256 + lane * 4); sq += (v[i][0] * v[i][0] + v[i][1] * v[i][1]) + (v[i][2] * v[i][2] + v[i][3] * v[i][3]); }
#pragma unroll
        for (int s = 1; s < 64; s <<= 1) sq += __shfl_xor(sq, s);
        const float r = rsqrtf(sq * (1.0f / 1024.0f) + 1e-6f);
#pragma unroll
        for (int i = 0; i < 4; ++i) {
            const f32x4 g = *(const f32x4*)(mg + i * 256 + lane * 4);
            u32x2 o; o[0] = pk2(v[i][0] * r * g[0], v[i][1] * r * g[1]); o[1] = pk2(v[i][2] * r * g[2], v[i][3] * r * g[3]);
            *(u32x2*)(memn + (size_t)row * DM + i * 256 + lane * 4) = o;
        }
    }
}


__device__ void kv_phase(unsigned char* lds_g, const Params& P) {
    LAS float* red = (LAS float*)lds_g;
    const int tid = threadIdx.x, lane = tid & 63, wave = tid >> 6, fr = lane & 15, fq = lane >> 4;
    const bf16_t* memn = (const bf16_t*)(P.ws + WS_MEMN); const bf16_t* Wt = (const bf16_t*)(P.ws + WS_W + OW_KV);
    bf16_t* Kb = (bf16_t*)(P.ws + WS_KB); bf16_t* Vt = (bf16_t*)(P.ws + WS_VT);
    for (int tile = blockIdx.x; tile < 256; tile += gridDim.x) {
        const int tm = tile >> 5, tn = tile & 31;
        f32x4 acc[4][4];
#pragma unroll
        for (int i = 0; i < 4; ++i)
#pragma unroll
            for (int j = 0; j < 4; ++j) acc[i][j] = (f32x4){0.f, 0.f, 0.f, 0.f};
#pragma unroll
        for (int ks = 0; ks < 4; ++ks) {
            const int k = wave * 128 + ks * 32 + fq * 8;
            bf16x8 af[4], bf[4];
#pragma unroll
            for (int i = 0; i < 4; ++i) { af[i] = *(const bf16x8*)(memn + (size_t)(64 * tm + 16 * i + fr) * DM + k); bf[i] = *(const bf16x8*)(Wt + (size_t)(64 * tn + 16 * i + fr) * DM + k); }
#pragma unroll
            for (int mb = 0; mb < 4; ++mb)
#pragma unroll
                for (int nb = 0; nb < 4; ++nb) acc[mb][nb] = __builtin_amdgcn_mfma_f32_16x16x32_bf16(bf[nb], af[mb], acc[mb][nb], 0, 0, 0);
        }
        __syncthreads();
#pragma unroll
        for (int mb = 0; mb < 4; ++mb)
#pragma unroll
            for (int nb = 0; nb < 4; ++nb) *(LAS f32x4*)(red + (wave * 64 + 16 * mb + fr) * 64 + 16 * nb + 4 * fq) = acc[mb][nb];
        __syncthreads();
        const int b = tm >> 2, mbase = (tm & 3) * 64, col = (tn & 15) * 64, h = col >> 8, d0 = col & 255;
        float v[8];
#pragma unroll
        for (int j = 0; j < 8; ++j) v[j] = 0.f;
        if (tn < 16) {
            const int m = tid >> 3, n8 = (tid & 7) * 8;
#pragma unroll
            for (int w = 0; w < 8; ++w) { const f32x4 x0 = *(const LAS f32x4*)(red + (w * 64 + m) * 64 + n8), x1 = *(const LAS f32x4*)(red + (w * 64 + m) * 64 + n8 + 4);
#pragma unroll
                for (int j = 0; j < 4; ++j) { v[j] += x0[j]; v[4 + j] += x1[j]; } }
            u32x4 o; o[0] = pk2(v[0], v[1]); o[1] = pk2(v[2], v[3]); o[2] = pk2(v[4], v[5]); o[3] = pk2(v[6], v[7]);
            *(u32x4*)(Kb + ((size_t)(b * 4 + h) * 256 + mbase + m) * 256 + d0 + n8) = o;
        } else {
            const int n = tid >> 3, p8 = (tid & 7) * 8;
#pragma unroll
            for (int e = 0; e < 8; ++e) {
                const int pp = p8 + e, key = (pp & 32) | (((pp >> 2) & 1) << 4) | (((pp >> 3) & 3) << 2) | (pp & 3);
#pragma unroll
                for (int w = 0; w < 8; ++w) v[e] += red[(w * 64 + key) * 64 + n];
            }
            u32x4 o; o[0] = pk2(v[0], v[1]); o[1] = pk2(v[2], v[3]); o[2] = pk2(v[4], v[5]); o[3] = pk2(v[6], v[7]);
            *(u32x4*)(Vt + ((size_t)(b * 4 + h) * 256 + d0 + n) * 256 + mbase + p8) = o;
        }
    }
    __syncthreads();
}

__device__ void final_phase(const Params& P) {
    const int tid = threadIdx.x, lane = tid & 63, gw = blockIdx.x * 8 + (tid >> 6), nw = gridDim.x * 8;
    const bf16_t* h = (const bf16_t*)(P.ws + WS_HB); float* out = P.out; const float* ss = (const float*)(P.ws + WS_SS); const float* g = P.in[27];
    f32x4 gg[4];
#pragma unroll
    for (int i = 0; i < 4; ++i) gg[i] = *(const f32x4*)(g + i * 256 + lane * 4);
    for (int row = gw; row < MTOK; row += nw) {
        const float r = row_rs(ss, row);
#pragma unroll
        for (int i = 0; i < 4; ++i) {
            const u32x2 x = *(const u32x2*)(h + (size_t)row * DM + i * 256 + lane * 4);
            f32x4 v; v[0] = bflo(x[0]); v[1] = bfhi(x[0]); v[2] = bflo(x[1]); v[3] = bfhi(x[1]);
            *(f32x4*)(out + (size_t)row * DM + i * 256 + lane * 4) = v * r * gg[i];
        }
    }
}

template <int N> __device__ __forceinline__ void bfly(float (&v)[64], int lane) {
    const bool hi = (lane & N) != 0;
#pragma unroll
    for (int k = 0; k < N; ++k) { const float send = hi ? v[k] : v[k + N]; const float keep = hi ? v[k + N] : v[k]; v[k] = keep + __shfl_xor(send, N); }
}
constexpr int CT = 32, CROWS = CT + 30;
template <int S> __device__ __forceinline__ void conv_row(f32x2 (&acc)[CT], const f32x2 (&w)[31], const LAS unsigned char* lp) {
    const unsigned wv = *(const LAS unsigned*)(lp + S * 2048);
    f32x2 av; av[0] = bflo(wv); av[1] = bfhi(wv);
#pragma unroll
    for (int t = 0; t < CT; ++t) { if (S - t >= 0 && S - t <= 30) acc[t] += w[(S - t >= 0 && S - t <= 30) ? S - t : 0] * av; }
}
template <int... S> __device__ __forceinline__ void conv_all(f32x2 (&acc)[CT], const f32x2 (&w)[31], const LAS unsigned char* lp, std::integer_sequence<int, S...>) { (conv_row<S>(acc, w, lp), ...); }
__device__ void conv_phase(unsigned char* lds_g, const Params& P) {
    LAS unsigned char* lds = (LAS unsigned char*)lds_g;
    LAS float* red = (LAS float*)(lds + CROWS * 2048); LAS float* stat = red + 512;
    const int tid = threadIdx.x, lane = tid & 63, wave = tid >> 6, G = gridDim.x;
    const bf16_t* a = (const bf16_t*)(P.ws + WS_R1); bf16_t* ac = (bf16_t*)P.out;
    const float* cw = P.in[8];
    f32x2 w[31];
#pragma unroll
    for (int j = 0; j < 31; ++j) w[j] = *(const f32x2*)(cw + j * 1024 + 2 * tid);
    const f32x2 cb = *(const f32x2*)(P.in[9] + 2 * tid), lg = *(const f32x2*)(P.in[10] + 2 * tid), lb = *(const f32x2*)(P.in[11] + 2 * tid);
    for (int tile = blockIdx.x; tile < MTOK / CT; tile += G) {
        const int t0 = tile * CT, tin = t0 & (SEQ - 1);
#pragma unroll
        for (int i = 0; i < 16; ++i) {
            const int c = tid + NTHR * i, r = c >> 7, cc = c & 127;
            u32x4 v = {0u, 0u, 0u, 0u};
            if (r < CROWS && tin - 30 + r >= 0) v = *(const u32x4*)(a + (size_t)(t0 - 30 + r) * DM + cc * 8);
            if (r < CROWS) *(LAS u32x4*)(lds + r * 2048 + cc * 16) = v;
        }
        __syncthreads();
        f32x2 acc[CT];
#pragma unroll
        for (int t = 0; t < CT; ++t) acc[t] = cb;
        conv_all(acc, w, lds + tid * 4, std::make_integer_sequence<int, CROWS>{});
        float v[64];
#pragma unroll
        for (int t = 0; t < CT; ++t) { v[t] = acc[t][0] + acc[t][1]; v[32 + t] = acc[t][0] * acc[t][0] + acc[t][1] * acc[t][1]; }
        bfly<32>(v, lane); bfly<16>(v, lane); bfly<8>(v, lane); bfly<4>(v, lane); bfly<2>(v, lane); bfly<1>(v, lane);
        red[wave * 64 + lane] = v[0];
        __syncthreads();
        if (tid < 64) { float s = 0.f;
#pragma unroll
            for (int q = 0; q < 8; ++q) s += red[q * 64 + tid];
            stat[tid] = s; }
        __syncthreads();
#pragma unroll
        for (int t = 0; t < CT; ++t) {
            const float mean = stat[t] * (1.0f / 1024.0f), var = stat[32 + t] * (1.0f / 1024.0f) - mean * mean, rstd = rsqrtf(var + 1e-5f);
            const float y0 = (acc[t][0] - mean) * rstd * lg[0] + lb[0], y1 = (acc[t][1] - mean) * rstd * lg[1] + lb[1];
            *(unsigned*)(ac + (size_t)(t0 + t) * (2 * DM) + 2 * tid) = pk2(fsilu(y0), fsilu(y1));
        }
    }
    __syncthreads();
}

__device__ void sgu_phase(unsigned char* lds_g, const Params& P) {
    LAS unsigned char* lds = (LAS unsigned char*)lds_g;
    LAS unsigned char* Wl = lds;
    LAS unsigned char* Vl = lds + 128 * 272;
    LAS float* stat = (LAS float*)(lds + 128 * 272 + 128 * 520);
    const int tid = threadIdx.x, lane = tid & 63, wave = tid >> 6, fr = lane & 15, fq = lane >> 4, G = gridDim.x;
    const bf16_t* gv = (const bf16_t*)(P.ws + WS_R1 + 2 * SLOT);
    bf16_t* xr = (bf16_t*)P.out + DM;
    const float* vst = (const float*)(P.ws + WS_VST);
    const float* lng = P.in[13]; const float* lnb = P.in[14]; const float* sw = P.in[15]; const float* sbias = P.in[16];
    int lastg = -1;
    for (int u = blockIdx.x; u < 1024; u += G) {
        const int c = u >> 2, g = u & 3;
        __syncthreads();
        if (g != lastg) {
            lastg = g;
#pragma unroll
            for (int i = 0; i < 4; ++i) {
                const int e = tid + NTHR * i, t = e >> 4, s8 = (e & 15) * 8;
                const float* sp = sw + ((size_t)g * 128 + t) * 128 + s8;
                const f32x4 x0 = *(const f32x4*)sp, x1 = *(const f32x4*)(sp + 4);
                float f[8] = {x0[0], x0[1], x0[2], x0[3], x1[0], x1[1], x1[2], x1[3]};
#pragma unroll
                for (int j = 0; j < 8; ++j) if (s8 + j > t) f[j] = 0.f;
                u32x4 o; o[0] = pk2(f[0], f[1]); o[1] = pk2(f[2], f[3]); o[2] = pk2(f[4], f[5]); o[3] = pk2(f[6], f[7]);
                *(LAS u32x4*)(Wl + t * 272 + s8 * 2) = o;
            }
        }
        if (tid < 128) {
            const f32x4* p = (const f32x4*)(vst + (size_t)(c * 128 + tid) * 32);
            float s1 = 0.f, s2 = 0.f;
#pragma unroll
            for (int q = 0; q < 8; ++q) { const f32x4 x = p[q]; s1 += x[0] + x[2]; s2 += x[1] + x[3]; }
            const float mean = s1 * (1.0f / 1024.0f), var = s2 * (1.0f / 1024.0f) - mean * mean;
            stat[tid * 2] = mean; stat[tid * 2 + 1] = rsqrtf(var + 1e-5f);
        }
        __syncthreads();
#pragma unroll
        for (int i = 0; i < 8; ++i) {
            const int e = tid + NTHR * i, s = e >> 5, c8 = (e & 31) * 8;
            const u32x4 raw = *(const u32x4*)(gv + (size_t)(c * 128 + s) * DM + g * 256 + c8);
            const float mean = stat[s * 2], rstd = stat[s * 2 + 1];
            const f32x4 g0 = *(const f32x4*)(lng + g * 256 + c8), g1 = *(const f32x4*)(lng + g * 256 + c8 + 4), b0 = *(const f32x4*)(lnb + g * 256 + c8), b1 = *(const f32x4*)(lnb + g * 256 + c8 + 4);
            float f[8] = {bflo(raw[0]), bfhi(raw[0]), bflo(raw[1]), bfhi(raw[1]), bflo(raw[2]), bfhi(raw[2]), bflo(raw[3]), bfhi(raw[3])};
#pragma unroll
            for (int j = 0; j < 4; ++j) { f[j] = (f[j] - mean) * rstd * g0[j] + b0[j]; f[4 + j] = (f[4 + j] - mean) * rstd * g1[j] + b1[j]; }
            u32x2 o0, o1; o0[0] = pk2(f[0], f[1]); o0[1] = pk2(f[2], f[3]); o1[0] = pk2(f[4], f[5]); o1[1] = pk2(f[6], f[7]);
            *(LAS u32x2*)(Vl + s * 520 + c8 * 2) = o0; *(LAS u32x2*)(Vl + s * 520 + c8 * 2 + 8) = o1;
        }
        __syncthreads();
        f32x4 acc[2][8];
#pragma unroll
        for (int db = 0; db < 2; ++db)
#pragma unroll
            for (int tb = 0; tb < 8; ++tb) acc[db][tb] = (f32x4){0.f, 0.f, 0.f, 0.f};
#pragma unroll
        for (int ks = 0; ks < 4; ++ks) {
            bf16x8 vf[2];
#pragma unroll
            for (int db = 0; db < 2; ++db)
#pragma unroll
                for (int e = 0; e < 8; ++e) vf[db][e] = *(const LAS short*)(Vl + (32 * ks + 8 * fq + e) * 520 + (32 * wave + 16 * db + fr) * 2);
#pragma unroll
            for (int tb = 0; tb < 8; ++tb) {
                if (16 * tb + 15 >= 32 * ks) {
                    const bf16x8 wf = *(const LAS bf16x8*)(Wl + (16 * tb + fr) * 272 + (32 * ks + 8 * fq) * 2);
#pragma unroll
                    for (int db = 0; db < 2; ++db) acc[db][tb] = __builtin_amdgcn_mfma_f32_16x16x32_bf16(vf[db], wf, acc[db][tb], 0, 0, 0);
                }
            }
        }
#pragma unroll
        for (int tb = 0; tb < 8; ++tb) {
            const int t = 16 * tb + fr; const size_t row = (size_t)c * 128 + t; const float bias = sbias[g * 128 + t];
#pragma unroll
            for (int db = 0; db < 2; ++db) {
                const size_t o = row * (2 * DM) + g * 256 + 32 * wave + 16 * db + 4 * fq;
                const u32x2 uu = *(const u32x2*)(xr + o);
                u32x2 w; w[0] = pk2(bflo(uu[0]) * (acc[db][tb][0] + bias), bfhi(uu[0]) * (acc[db][tb][1] + bias)); w[1] = pk2(bflo(uu[1]) * (acc[db][tb][2] + bias), bfhi(uu[1]) * (acc[db][tb][3] + bias));
                *(u32x2*)(xr + o) = w;
            }
        }
    }
    __syncthreads();
}

__device__ void attn_phase(unsigned char* lds_g, const Params& P) {
    LAS unsigned char* lds = (LAS unsigned char*)lds_g;
    const int tid = threadIdx.x, lane = tid & 63, wave = tid >> 6, fr = lane & 15, fq = lane >> 4, G = gridDim.x;
    const bf16_t* q = (const bf16_t*)(P.ws + WS_R1 + 3 * SLOT); bf16_t* o = (bf16_t*)(P.ws + WS_R1 + 4 * SLOT);
    const bf16_t* Kb = (const bf16_t*)(P.ws + WS_KB); const bf16_t* Vt = (const bf16_t*)(P.ws + WS_VT);
    for (int u = blockIdx.x; u < 512; u += G) {
        const int bh = u >> 6, qb = u & 63, b = bh >> 2, h = bh & 3;
        const size_t rowq = (size_t)b * SEQ + qb * 256 + wave * 32 + fr;
        __syncthreads();
#pragma unroll
        for (int i = 0; i < 16; ++i) {
            const int e = tid + NTHR * i, r = e >> 5, cc = e & 31;
            *(LAS u32x4*)(lds + r * 528 + cc * 16) = *(const u32x4*)(Kb + ((size_t)bh * 256 + r) * 256 + cc * 8);
        }
        const bf16_t* qp = q + rowq * DM + h * 256 + fq * 8;
        bf16x8 qn0 = *(const bf16x8*)qp, qn1 = *(const bf16x8*)(qp + 16 * DM);
        __syncthreads();
        f32x4 S[16][2];
#pragma unroll
        for (int kb = 0; kb < 16; ++kb) { S[kb][0] = (f32x4){0.f, 0.f, 0.f, 0.f}; S[kb][1] = (f32x4){0.f, 0.f, 0.f, 0.f}; }
#pragma unroll 1
        for (int ks = 0; ks < 8; ++ks) {
            const bf16x8 q0 = qn0, q1 = qn1;
            const int kn = ks < 7 ? ks + 1 : 7;
            qn0 = *(const bf16x8*)(qp + kn * 32); qn1 = *(const bf16x8*)(qp + 16 * DM + kn * 32);
            const LAS unsigned char* kp = lds + fr * 528 + (32 * ks + 8 * fq) * 2;
#pragma unroll
            for (int kb = 0; kb < 16; ++kb) {
                const bf16x8 kf = *(const LAS bf16x8*)(kp + kb * 16 * 528);
                S[kb][0] = __builtin_amdgcn_mfma_f32_16x16x32_bf16(kf, q0, S[kb][0], 0, 0, 0);
                S[kb][1] = __builtin_amdgcn_mfma_f32_16x16x32_bf16(kf, q1, S[kb][1], 0, 0, 0);
                if ((kb & 3) == 3) __builtin_amdgcn_sched_barrier(0);
            }
        }
        float inv[2];
#pragma unroll
        for (int nb = 0; nb < 2; ++nb) {
            float mx = -3.0e38f;
#pragma unroll
            for (int kb = 0; kb < 16; ++kb) mx = fmaxf(fmaxf(fmaxf(S[kb][nb][0], S[kb][nb][1]), fmaxf(S[kb][nb][2], S[kb][nb][3])), mx);
            mx = fmaxf(mx, __shfl_xor(mx, 16)); mx = fmaxf(mx, __shfl_xor(mx, 32));
            float sum = 0.f;
#pragma unroll
            for (int kb = 0; kb < 16; ++kb)
#pragma unroll
                for (int j = 0; j < 4; ++j) { const float p = __expf(S[kb][nb][j] - mx); S[kb][nb][j] = p; sum += p; }
            sum = xor16_32_sum(sum);
            inv[nb] = 1.0f / sum;
        }
        bf16x8 pf[8][2];
#pragma unroll
        for (int c = 0; c < 8; ++c)
#pragma unroll
            for (int nb = 0; nb < 2; ++nb) {
                u32x4 w; w[0] = pk2(S[2 * c][nb][0], S[2 * c][nb][1]); w[1] = pk2(S[2 * c][nb][2], S[2 * c][nb][3]); w[2] = pk2(S[2 * c + 1][nb][0], S[2 * c + 1][nb][1]); w[3] = pk2(S[2 * c + 1][nb][2], S[2 * c + 1][nb][3]);
                pf[c][nb] = __builtin_bit_cast(bf16x8, w);
            }
        __syncthreads();
        __builtin_amdgcn_sched_barrier(0);
#pragma unroll
        for (int i = 0; i < 16; ++i) {
            const int e = tid + NTHR * i, r = e >> 5, cc = e & 31;
            *(LAS u32x4*)(lds + r * 528 + cc * 16) = *(const u32x4*)(Vt + ((size_t)bh * 256 + r) * 256 + cc * 8);
        }
        __syncthreads();
#pragma unroll 1
        for (int dq = 0; dq < 4; ++dq) {
            const LAS unsigned char* vp = lds + (64 * dq + fr) * 528 + 16 * fq;
            f32x4 O[4][2];
#pragma unroll
            for (int db = 0; db < 4; ++db) { O[db][0] = (f32x4){0.f, 0.f, 0.f, 0.f}; O[db][1] = (f32x4){0.f, 0.f, 0.f, 0.f}; }
#pragma unroll
            for (int db = 0; db < 4; ++db)
#pragma unroll
                for (int c = 0; c < 8; ++c) {
                    const bf16x8 vf = *(const LAS bf16x8*)(vp + db * 16 * 528 + c * 64);
                    O[db][0] = __builtin_amdgcn_mfma_f32_16x16x32_bf16(vf, pf[c][0], O[db][0], 0, 0, 0);
                    O[db][1] = __builtin_amdgcn_mfma_f32_16x16x32_bf16(vf, pf[c][1], O[db][1], 0, 0, 0);
                }
#pragma unroll
            for (int nb = 0; nb < 2; ++nb)
#pragma unroll
                for (int db = 0; db < 4; ++db) {
                    u32x2 w; w[0] = pk2(O[db][nb][0] * inv[nb], O[db][nb][1] * inv[nb]); w[1] = pk2(O[db][nb][2] * inv[nb], O[db][nb][3] * inv[nb]);
                    *(u32x2*)(o + (rowq + nb * 16) * DM + h * 256 + 64 * dq + 16 * db + 4 * fq) = w;
                }
        }
    }
    __syncthreads();
}

#define XB_TMO      128
#define XB_XCNT(j)  (256  + 64 * (j))
#define XB_XSUB(j)  (1280 + 64 * (j))
#define XB_XGEN(j)  (2304 + 64 * (j))
#define XB_TOP      3328
#define XB_TOPGEN   3392
#define XCD_BAR_WORDS 3456
#define XB_SPIN_CAP (1u << 18)

__device__ __forceinline__ unsigned xb_ld(unsigned* p)              { return __hip_atomic_load(p, __ATOMIC_RELAXED, __HIP_MEMORY_SCOPE_AGENT); }
__device__ __forceinline__ unsigned xb_add(unsigned* p, unsigned v) { return __hip_atomic_fetch_add(p, v, __ATOMIC_RELAXED, __HIP_MEMORY_SCOPE_AGENT); }
__device__ __forceinline__ unsigned xb_xcc_id() { return (unsigned)__builtin_amdgcn_s_getreg((3 << 11) | 20) & 0xFu; }
#define XB_SPIN(cond, bar) do { unsigned _sp = 0; while (cond) { __builtin_amdgcn_s_sleep(1); \
    if ((++_sp & 255u) == 0u) { if (xb_ld(&(bar)[XB_TMO])) break; if (_sp > XB_SPIN_CAP) { atomicAdd(&(bar)[XB_TMO], 1u); break; } } } } while (0)

struct XcdBarrier {
    unsigned* bar; unsigned x;
    volatile LAS unsigned* st;
};

__device__ __forceinline__ XcdBarrier xcd_barrier_post(unsigned* bar, volatile LAS unsigned* st) {
    XcdBarrier b; b.bar = bar; b.x = xb_xcc_id(); b.st = st;
    if (threadIdx.x == 0) (void)xb_add(&bar[XB_XCNT(b.x)], 1u);
    return b;
}
__device__ __forceinline__ void xcd_barrier_complete(unsigned* bar, unsigned x, unsigned& nloc, unsigned& nx) {
    const unsigned G = gridDim.x * gridDim.y * gridDim.z;
    unsigned sum, cnt, mine, sp = 0u;
    for (;;) {
        sum = 0u; cnt = 0u; mine = 0u;
#pragma unroll
        for (unsigned j = 0; j < 16; ++j) { const unsigned c = xb_ld(&bar[XB_XCNT(j)]); sum += c; cnt += (c > 0u) ? 1u : 0u; mine = (j == x) ? c : mine; }
        if (sum == G) break;
        __builtin_amdgcn_s_sleep(1);
        if ((++sp & 255u) == 0u) { if (xb_ld(&bar[XB_TMO])) break; if (sp > XB_SPIN_CAP) { atomicAdd(&bar[XB_TMO], 1u); break; } }
    }
    nloc = mine > 0u ? mine : 1u; nx = cnt > 0u ? cnt : 1u;
}

__device__ __forceinline__ void xcd_barrier(const XcdBarrier& b) {
    asm volatile("s_waitcnt vmcnt(0)" ::: "memory");
    __syncthreads();
    if (threadIdx.x == 0) {
        unsigned* bar = b.bar;
        __builtin_amdgcn_s_waitcnt(0);
        unsigned nloc = b.st[0], nx = b.st[1];
        if (nloc == 0u) { xcd_barrier_complete(bar, b.x, nloc, nx); b.st[0] = nloc; b.st[1] = nx; }
        const unsigned old = xb_add(&bar[XB_XSUB(b.x)], 1u);
        const unsigned gen = old / nloc;
        if (old + 1u == (gen + 1u) * nloc) {
            __builtin_amdgcn_fence(__ATOMIC_RELEASE, "agent");
            asm volatile("s_waitcnt vmcnt(0)" ::: "memory");
            const unsigned og = xb_add(&bar[XB_TOP], 1u);
            const unsigned tg = og / nx;
            if (og + 1u == (tg + 1u) * nx) xb_add(&bar[XB_TOPGEN], 1u);
            else XB_SPIN(xb_ld(&bar[XB_TOPGEN]) == tg, bar);
            __builtin_amdgcn_fence(__ATOMIC_ACQUIRE, "agent");
            xb_add(&bar[XB_XGEN(b.x)], 1u);
            asm volatile("s_waitcnt vmcnt(0)" ::: "memory");
        } else {
            XB_SPIN(xb_ld(&bar[XB_XGEN(b.x)]) == gen, bar);
            __builtin_amdgcn_fence(__ATOMIC_ACQUIRE, "agent");
            asm volatile("s_waitcnt vmcnt(0)" ::: "memory");
        }
    }
    __syncthreads();
}

template <class Epi> __device__ __forceinline__ void run_gemm(unsigned char* lds, const bf16_t* A, const bf16_t* Bt, int M, int N, int K, const Epi& E) {
    pg8::Gemm g{A, Bt, M, N, K}; pg8::StaticOrder S; S.init(M, N, (int)gridDim.x, (int)blockIdx.x);
    pg8::gemm_phase<Epi, pg8::StaticOrder, true, true>((PG8_LAS unsigned char*)lds, g, S, E);
}

__global__ void __launch_bounds__(NTHR, 2) mega_fwd(Params P) {
    extern __shared__ __attribute__((aligned(16))) unsigned char lds[];
    cg::grid_group grid = cg::this_grid();
    const int lo = P.ph_lo, hi = P.ph_hi;
    unsigned char* ws = P.ws;
    bf16_t* W = (bf16_t*)(ws + WS_W);
    bf16_t* HB = (bf16_t*)(ws + WS_HB);
    bf16_t* S0 = (bf16_t*)(ws + WS_R1), *S1 = (bf16_t*)(ws + WS_R1 + SLOT), *S3 = (bf16_t*)(ws + WS_R1 + 3 * SLOT), *S4 = (bf16_t*)(ws + WS_R1 + 4 * SLOT);
    bf16_t* X = (bf16_t*)P.out;
    float* SS = (float*)(ws + WS_SS); float* VST = (float*)(ws + WS_VST);
#ifndef PHMASK
#define PHMASK 0x1fff
#endif
#define IN(k) (((PHMASK >> (k)) & 1) && lo <= (k) && (k) < hi)
#define SEAM(k) do { if (IN(k) && IN((k) + 1)) { if ((k) == 0) grid.sync(); else xcd_barrier(xb); } } while (0)
    volatile LAS unsigned* xst = (volatile LAS unsigned*)((LAS unsigned char*)lds + LDS_IMG);
    if (threadIdx.x == 0) { xst[0] = 0u; xst[1] = 0u; }
    __syncthreads();
    XcdBarrier xb; xb.bar = (unsigned*)(ws + WS_BAR); xb.x = 0; xb.st = xst;
    if (hi - lo > 1) xb = xcd_barrier_post((unsigned*)(ws + WS_BAR), xst);
    if (IN(0)) prep_phase(lds, P);
    SEAM(0);
    if (IN(1)) {
        kv_phase(lds, P);
        run_gemm(lds, HB, (const bf16_t*)((unsigned char*)W + OW_GU1), MTOK, 2 * DFF, DM, EpiSwiglu{S0, SS});
    }
    SEAM(1);
    if (IN(2)) run_gemm(lds, S0, (const bf16_t*)((unsigned char*)W + OW_DN1), MTOK, DM, DFF, EpiRes{HB, SS, 0.5f});
    SEAM(2);
    if (IN(3)) run_gemm(lds, HB, (const bf16_t*)((unsigned char*)W + OW_IN), MTOK, DIN, DM, EpiWin{SS, P.in[7], S0, S1, VST, X + DM});
    SEAM(3);
    if (IN(4)) { conv_phase(lds, P); sgu_phase(lds, P); }
    SEAM(4);
    if (IN(5)) run_gemm(lds, X, (const bf16_t*)((unsigned char*)W + OW_A), MTOK, DM, 2 * DM, EpiDual{S3, S4, S1});
    SEAM(5);
    if (IN(6)) run_gemm(lds, S1, (const bf16_t*)((unsigned char*)W + OW_OUT), MTOK, DM, DM, EpiRes{HB, SS, 1.0f});
    SEAM(6);
    if (IN(7)) run_gemm(lds, HB, (const bf16_t*)((unsigned char*)W + OW_Q), MTOK, DM, DM, EpiGate<2>{nullptr, nullptr, S3, SS});
    SEAM(7);
    if (IN(8)) attn_phase(lds, P);
    SEAM(8);
    if (IN(9)) run_gemm(lds, S4, (const bf16_t*)((unsigned char*)W + OW_O), MTOK, DM, DM, EpiRes{HB, SS, 1.0f});
    SEAM(9);
    if (IN(10)) run_gemm(lds, HB, (const bf16_t*)((unsigned char*)W + OW_GU2), MTOK, 2 * DFF, DM, EpiSwiglu{S0, SS});
    SEAM(10);
    if (IN(11)) run_gemm(lds, S0, (const bf16_t*)((unsigned char*)W + OW_DN2), MTOK, DM, DFF, EpiRes{HB, SS, 0.5f});
    SEAM(11);
    if (IN(12)) final_phase(P);
#undef IN
#undef SEAM
}
constexpr int NPHASE = 13;

#ifndef DBL
#define DBL 0
#endif
#ifndef N_LAUNCH_PER_PHASE
#define N_LAUNCH_PER_PHASE 0
#endif

extern "C" void kernel_launch(void* const* d_in, const int* in_sizes, int n_in, void* d_out, int out_size, void* d_ws, size_t ws_size, hipStream_t stream) {
    static int grid_blocks = 0;
    if (!grid_blocks) {
        int dev = 0, cus = 0, per_cu = 0;
        hipGetDevice(&dev);
        hipDeviceGetAttribute(&cus, hipDeviceAttributeMultiprocessorCount, dev);
        hipFuncSetAttribute((const void*)mega_fwd, hipFuncAttributeMaxDynamicSharedMemorySize, LDS_BYTES);
        hipOccupancyMaxActiveBlocksPerMultiprocessor(&per_cu, (const void*)mega_fwd, NTHR, LDS_BYTES);
        if (per_cu < 1) { fprintf(stderr, "occupancy query says %d blocks/CU\n", per_cu); per_cu = 1; }
        grid_blocks = cus * per_cu;
        if (ws_size < WS_END || n_in != 28) fprintf(stderr, "unexpected ws_size %zu / n_in %d\n", ws_size, n_in);
    }
    Params p;
    memset(&p, 0, sizeof(p));
    for (int i = 0; i < 28; ++i) p.in[i] = (const float*)d_in[i];
    p.out = (float*)d_out; p.ws = (unsigned char*)d_ws;
    unsigned char* W = (unsigned char*)d_ws + WS_W;
    auto setw = [&](int i, int src, size_t off, int K, int Nsrc, int Nout, int mode, int ksc, float csc) {
        p.wd[i].src = (const float*)d_in[src]; p.wd[i].dst = (bf16_t*)(W + off); p.wd[i].ksc = ksc >= 0 ? (const float*)d_in[ksc] : nullptr;
        p.wd[i].K = K; p.wd[i].Nsrc = Nsrc; p.wd[i].Nout = Nout; p.wd[i].mode = mode; p.wd[i].csc = csc; p.wd[i].ldd = K; };
    setw(0, 3, OW_GU1, 1024, 5632, 5632, 1, 2, 1.0f);
    setw(1, 4, OW_DN1, 2816, 1024, 1024, 0, -1, 1.0f);
    setw(2, 6, OW_IN, 1024, 6144, 6144, 2, 5, 1.0f);
    setw(3, 12, OW_A, 1024, 1024, 1024, 0, -1, 1.0f);
    setw(4, 17, OW_A + 2048, 1024, 1024, 1024, 0, -1, 1.0f);
    p.wd[3].ldd = 2048; p.wd[4].ldd = 2048;
    setw(5, 18, OW_OUT, 1024, 1024, 1024, 0, -1, 1.0f);
    setw(6, 21, OW_Q, 1024, 1024, 1024, 0, 19, 0.0625f);
    setw(7, 23, OW_O, 1024, 1024, 1024, 0, -1, 1.0f);
    setw(8, 22, OW_KV, 1024, 2048, 2048, 0, -1, 1.0f);
    setw(9, 25, OW_GU2, 1024, 5632, 5632, 1, 24, 1.0f);
    setw(10, 26, OW_DN2, 2816, 1024, 1024, 0, -1, 1.0f);
#if N_LAUNCH_PER_PHASE
    for (int ph = 0; ph < NPHASE; ++ph) {
        p.ph_lo = ph; p.ph_hi = ph + 1;
        for (int r = 0; r <= ((DBL >> ph) & 1); ++r) hipLaunchKernelGGL(mega_fwd, dim3(grid_blocks), dim3(NTHR), LDS_BYTES, stream, p);
    }
#else
    p.ph_lo = 0; p.ph_hi = NPHASE;
    (void)hipMemsetAsync((unsigned char*)d_ws + WS_BAR, 0, XCD_BAR_WORDS * 4, stream);
    void* args[] = {&p};
    hipError_t e = hipLaunchCooperativeKernel((const void*)mega_fwd, dim3(grid_blocks), dim3(NTHR), args, LDS_BYTES, stream);
    if (e != hipSuccess) fprintf(stderr, "cooperative launch failed: %s (grid %d)\n", hipGetErrorString(e), grid_blocks);
#endif
}
```
